# Optimizing an MI355X kernel written in HIP

```python
import math
import jax, jax.numpy as jnp
from jax import lax
import numpy as np

D_MODEL = 1024
BATCH = 2
SEQ = 16384
DEPTH = 1
DEC_BATCH = 32
DEC_SEQ = 2048
PAST_LEN = 128

HYENA_WIDTH = 512
ATTN_WIDTH = 512
N_DIFF_HEADS = 4
DIFF_HEAD_DIM = 64
DIFF_V_DIM = 2 * DIFF_HEAD_DIM
ROT_DIM = DIFF_HEAD_DIM // 4
ROPE_THETA = 500000.0
D_IN = 3 * HYENA_WIDTH + 3 * ATTN_WIDTH
D_FF = 4 * D_MODEL
FILTER_EMB = 33
FILTER_ORDER = 64
FAST_DECAY_PCT = 0.3
SLOW_DECAY_PCT = 1.5
DECAY_TARGET = 1e-2
Q_BLOCK = 128
NORM_EPS = 1e-6
SUBLN_EPS = 1e-5

kernel_name = "hymba_hyena_diffattn_adaln_encoder"


def rms_norm(x, w, eps=NORM_EPS):
    xf = x.astype(jnp.float32)
    y = xf * lax.rsqrt(jnp.mean(xf * xf, axis=-1, keepdims=True) + eps)
    return (y * w.astype(jnp.float32)).astype(x.dtype)


def implicit_filter(L, w1, b1, w2, b2, w3, b3, w4, freq):
    f32 = jnp.float32
    C = HYENA_WIDTH
    t = jnp.linspace(0.0, 1.0, L, dtype=f32)[:, None]
    bands = (FILTER_EMB - 1) // 2
    w = (2.0 * math.pi) * jnp.arange(L, dtype=f32)[:, None] / L
    f = jnp.linspace(1e-4, bands - 1, bands, dtype=f32)[None, :]
    z = jnp.concatenate([t, jnp.cos(f * w), -jnp.sin(f * w)], axis=-1)
    fr = freq.astype(f32)
    h = jnp.sin(fr * (z @ w1.astype(f32) + b1.astype(f32)))
    h = jnp.sin(fr * (h @ w2.astype(f32) + b2.astype(f32)))
    h = jnp.sin(fr * (h @ w3.astype(f32) + b3.astype(f32)))
    h = h @ w4.astype(f32)
    min_decay = math.log(DECAY_TARGET) / SLOW_DECAY_PCT
    max_decay = math.log(DECAY_TARGET) / FAST_DECAY_PCT
    deltas = jnp.linspace(min_decay, max_decay, C, dtype=f32)
    decay = jnp.exp(-t * jnp.abs(deltas)[None, :])
    h_f = h[:, :C] * decay
    h_b = h[:, C:] * decay
    return jnp.concatenate([h_f.at[0].add(h_b[0]), jnp.zeros((1, C), f32), h_b[:0:-1]], axis=0)


def hyena_mixer(u, conv_w, conv_b, filt_w1, filt_b1, filt_w2, filt_b2, filt_w3, filt_b3, filt_w4,
                filt_freq, hyena_bias, hyena_norm_w):
    B, L, _ = u.shape
    up = jnp.pad(u, ((0, 0), (1, 1), (0, 0)))
    u = up[:, :L] * conv_w[0] + up[:, 1:L + 1] * conv_w[1] + up[:, 2:] * conv_w[2] + conv_b
    x0, x1, v = jnp.split(u, 3, axis=-1)
    s = (x1 * v).astype(jnp.float32)
    k = implicit_filter(L, filt_w1, filt_b1, filt_w2, filt_b2, filt_w3, filt_b3, filt_w4, filt_freq)
    n = 2 * L
    y = jnp.fft.irfft(jnp.fft.rfft(s, n=n, axis=1) * jnp.fft.rfft(k, n=n, axis=0)[None], n=n, axis=1)[:, :L]
    y = x0.astype(jnp.float32) * (y + s * hyena_bias.astype(jnp.float32))
    return rms_norm(y, hyena_norm_w).astype(u.dtype)


def partial_rotary(x):
    L = x.shape[1]
    xf = x.astype(jnp.float32)
    inv_freq = ROPE_THETA ** (-jnp.arange(0, ROT_DIM, 2, dtype=jnp.float32) / ROT_DIM)
    ang = jnp.arange(L, dtype=jnp.float32)[:, None] * inv_freq[None, :]
    ang = jnp.concatenate([ang, ang], axis=-1)[None, :, None, :]
    xr, xp = xf[..., :ROT_DIM], xf[..., ROT_DIM:]
    x1, x2 = xr[..., :ROT_DIM // 2], xr[..., ROT_DIM // 2:]
    xr = xr * jnp.cos(ang) + jnp.concatenate([-x2, x1], axis=-1) * jnp.sin(ang)
    return jnp.concatenate([xr, xp], axis=-1)


def diff_attention(q, k, v, lambda_q1, lambda_k1, lambda_q2, lambda_k2, subln_w, lambda_init):
    B, L, _ = q.shape
    H, d, dv = N_DIFF_HEADS, DIFF_HEAD_DIM, DIFF_V_DIM
    q = partial_rotary(q.reshape(B, L, 2 * H, d)) * (d ** -0.5)
    k = partial_rotary(k.reshape(B, L, 2 * H, d))
    kh = k.transpose(0, 2, 1, 3)
    vh = v.reshape(B, L, H, dv).transpose(0, 2, 1, 3).astype(jnp.float32)
    f32 = jnp.float32
    lam = (jnp.exp(jnp.sum(lambda_q1.astype(f32) * lambda_k1.astype(f32)))
           - jnp.exp(jnp.sum(lambda_q2.astype(f32) * lambda_k2.astype(f32))) + lambda_init)
    nblk = L // Q_BLOCK
    qb = q.transpose(0, 2, 1, 3).reshape(B, 2 * H, nblk, Q_BLOCK, d).transpose(2, 0, 1, 3, 4)

    def block(qblk):
        s = jnp.einsum('bhqd,bhkd->bhqk', qblk, kh)
        p = jax.nn.softmax(s, axis=-1).reshape(B, H, 2, Q_BLOCK, L)
        a = p[:, :, 0] - lam * p[:, :, 1]
        return jnp.einsum('bhqk,bhkd->bhqd', a, vh)

    o = lax.map(block, qb)
    o = o.transpose(1, 0, 3, 2, 4).reshape(B, L, H, dv)
    o = rms_norm(o, subln_w, SUBLN_EPS) * (1.0 - lambda_init)
    return o.reshape(B, L, H * dv)


def encoder(x, c, w_ada, b_ada, norm1_w, w_in, conv_w, conv_b, filt_w1, filt_b1, filt_w2, filt_b2,
            filt_w3, filt_b3, filt_w4, filt_freq, hyena_bias, hyena_norm_w, lambda_q1, lambda_k1,
            lambda_q2, lambda_k2, subln_w, w_out, norm2_w, w_mlp1, w_mlp2, final_w):
    HW3 = 3 * HYENA_WIDTH
    for l in range(DEPTH):
        lambda_init = 0.8 - 0.6 * math.exp(-0.3 * l)
        mod = (jax.nn.silu(c) @ w_ada[l] + b_ada[l])[:, None, :]
        sh1, sc1, g1, sh2, sc2, g2 = jnp.split(mod, 6, axis=-1)
        h = rms_norm(x, norm1_w[l]) * (1.0 + sc1) + sh1
        p = h @ w_in[l]
        hy = hyena_mixer(p[..., :HW3], conv_w[l], conv_b[l], filt_w1[l], filt_b1[l], filt_w2[l],
                         filt_b2[l], filt_w3[l], filt_b3[l], filt_w4[l], filt_freq[l],
                         hyena_bias[l], hyena_norm_w[l])
        q = p[..., HW3:HW3 + ATTN_WIDTH]
        k = p[..., HW3 + ATTN_WIDTH:HW3 + 2 * ATTN_WIDTH]
        v = p[..., HW3 + 2 * ATTN_WIDTH:]
        at = diff_attention(q, k, v, lambda_q1[l], lambda_k1[l], lambda_q2[l], lambda_k2[l],
                            subln_w[l], lambda_init).astype(x.dtype)
        x = x + g1 * (jnp.concatenate([hy, at], axis=-1) @ w_out[l])
        h = rms_norm(x, norm2_w[l]) * (1.0 + sc2) + sh2
        x = x + g2 * (jnp.square(jax.nn.relu(h @ w_mlp1[l])) @ w_mlp2[l])
    return rms_norm(x, final_w)


def setup_inputs(seed: int = 0) -> dict:
    key = jax.random.key(seed)
    ks = jax.random.split(key, 32)
    f32 = jnp.float32
    nrm = lambda k, shape, s: jax.random.normal(k, shape, f32) * s
    D, L_ = D_MODEL, DEPTH
    return {
        "x_prompt": nrm(ks[0], (BATCH, SEQ, D), 1.0),
        "x_sample": nrm(ks[1], (DEC_BATCH, DEC_SEQ, D), 1.0),
        "c_prompt": nrm(ks[2], (BATCH, D), 1.0),
        "c_sample": nrm(ks[3], (DEC_BATCH, D), 1.0),
        "w_ada": nrm(ks[4], (L_, D, 6 * D), 0.5 * D ** -0.5),
        "b_ada": nrm(ks[5], (L_, 6 * D), 0.02),
        "norm1_w": 1.0 + nrm(ks[6], (L_, D), 0.02),
        "w_in": nrm(ks[7], (L_, D, D_IN), D ** -0.5),
        "conv_w": nrm(ks[8], (L_, 3, 3 * HYENA_WIDTH), 3 ** -0.5),
        "conv_b": nrm(ks[9], (L_, 3 * HYENA_WIDTH), 0.02),
        "filt_w1": nrm(ks[10], (L_, FILTER_EMB, FILTER_ORDER), FILTER_EMB ** -0.5),
        "filt_b1": nrm(ks[11], (L_, FILTER_ORDER), 0.1),
        "filt_w2": nrm(ks[12], (L_, FILTER_ORDER, FILTER_ORDER), FILTER_ORDER ** -0.5),
        "filt_b2": nrm(ks[13], (L_, FILTER_ORDER), 0.1),
        "filt_w3": nrm(ks[14], (L_, FILTER_ORDER, FILTER_ORDER), FILTER_ORDER ** -0.5),
        "filt_b3": nrm(ks[15], (L_, FILTER_ORDER), 0.1),
        "filt_w4": nrm(ks[16], (L_, FILTER_ORDER, 2 * HYENA_WIDTH), FILTER_ORDER ** -0.5),
        "filt_freq": 1.0 + nrm(ks[17], (L_, FILTER_ORDER), 0.1),
        "hyena_bias": nrm(ks[18], (L_, HYENA_WIDTH), 1.0),
        "hyena_norm_w": 1.0 + nrm(ks[19], (L_, HYENA_WIDTH), 0.02),
        "lambda_q1": nrm(ks[20], (L_, DIFF_HEAD_DIM), 0.1),
        "lambda_k1": nrm(ks[21], (L_, DIFF_HEAD_DIM), 0.1),
        "lambda_q2": nrm(ks[22], (L_, DIFF_HEAD_DIM), 0.1),
        "lambda_k2": nrm(ks[23], (L_, DIFF_HEAD_DIM), 0.1),
        "subln_w": 1.0 + nrm(ks[24], (L_, DIFF_V_DIM), 0.02),
        "w_out": nrm(ks[25], (L_, D, D), D ** -0.5),
        "norm2_w": 1.0 + nrm(ks[26], (L_, D), 0.02),
        "w_mlp1": nrm(ks[27], (L_, D, D_FF), D ** -0.5),
        "w_mlp2": nrm(ks[28], (L_, D_FF, D), D_FF ** -0.5),
        "final_w": 1.0 + nrm(ks[29], (D,), 0.02),
    }


def reference(x_prompt, x_sample, c_prompt, c_sample, w_ada, b_ada, norm1_w, w_in, conv_w, conv_b,
              filt_w1, filt_b1, filt_w2, filt_b2, filt_w3, filt_b3, filt_w4, filt_freq, hyena_bias,
              hyena_norm_w, lambda_q1, lambda_k1, lambda_q2, lambda_k2, subln_w, w_out, norm2_w,
              w_mlp1, w_mlp2, final_w):
    y_prompt = encoder(x_prompt, c_prompt, w_ada, b_ada, norm1_w, w_in, conv_w, conv_b, filt_w1, filt_b1,
                       filt_w2, filt_b2, filt_w3, filt_b3, filt_w4, filt_freq, hyena_bias, hyena_norm_w,
                       lambda_q1, lambda_k1, lambda_q2, lambda_k2, subln_w, w_out, norm2_w, w_mlp1,
                       w_mlp2, final_w)
    y_sample = encoder(x_sample, c_sample, w_ada, b_ada, norm1_w, w_in, conv_w, conv_b, filt_w1, filt_b1,
                       filt_w2, filt_b2, filt_w3, filt_b3, filt_w4, filt_freq, hyena_bias, hyena_norm_w,
                       lambda_q1, lambda_k1, lambda_q2, lambda_k2, subln_w, w_out, norm2_w, w_mlp1,
                       w_mlp2, final_w)
    return (y_prompt, y_sample)
```

```cpp
#include <hip/hip_runtime.h>
#include <hip/hip_cooperative_groups.h>
#include <cstdio>
#include <cstdint>
namespace cg = cooperative_groups;
namespace pg8 {
#define PG8_LAS __attribute__((address_space(3)))
typedef unsigned short bf16_t;
typedef short bf16x8 __attribute__((ext_vector_type(8)));
typedef float f32x4 __attribute__((ext_vector_type(4)));
typedef unsigned u32x4 __attribute__((ext_vector_type(4)));
constexpr int BM = 256, BK = 64, HALF = 128, HTB = HALF * BK * 2  , STAGE_BYTES = 8 * HTB, NXCD = 8, WGM = 8;

__host__ __device__ __forceinline__ int lds_byte(int r, int c) { const int st = (r >> 4) * 2 + (c >> 5), rr = r & 15, cc = c & 31, ob = rr * 64 + cc * 2; return st * 1024 + (ob ^ (((ob >> 9) & 1) << 5)); }
__host__ __device__ __forceinline__ void stage_rc(int b, int& R, int& C) { const int st = b / 1024, sb = b % 1024, swz = sb ^ (((sb >> 9) & 1) << 5); R = (st >> 1) * 16 + swz / 64; C = (st & 1) * 32 + (swz % 64) / 2; }
__host__ __device__ __forceinline__ int perm32(int rho) { const int n = rho >> 4, i = rho & 15; return 8 * (i >> 2) + 4 * n + (i & 3); }

struct Unit { int pm, pn; };
struct Gemm { const bf16_t* A; const bf16_t* Bt; int M, N, K; };

struct StaticOrder {
    int nM, nN, nwg, G, c;
    __host__ __device__ void init(int M, int N, int G_, int c_) { nM = M / BM; nN = N / BM; nwg = nM * nN; G = G_; c = c_; }
    __host__ __device__ bool next(int i, Unit& u) const {
        const long L = (long)i * G + c; if (L >= nwg) return false;
        int wgid = (int)L; { const int q = nwg / NXCD, r = nwg % NXCD, xcd = wgid % NXCD, off = wgid / NXCD; wgid = (xcd < r ? xcd * (q + 1) : r * (q + 1) + (xcd - r) * q) + off; }
        const int nig = WGM * nN, gid = wgid / nig, fm = gid * WGM, gsz = (nM - fm) < WGM ? (nM - fm) : WGM;
        u.pm = fm + ((wgid % nig) % gsz); u.pn = (wgid % nig) / gsz; return true;
    }
    __device__ __forceinline__ void a_ready(const Unit&) const {}
    __device__ __forceinline__ void done(const Unit&) const {}
};

typedef __bf16 pg8_bf16x2 __attribute__((ext_vector_type(2))); typedef float pg8_f32x2 __attribute__((ext_vector_type(2)));
__device__ __forceinline__ unsigned cvt_pk_bf16(float lo, float hi) { const pg8_f32x2 v = {lo, hi}; return __builtin_bit_cast(unsigned, __builtin_convertvector(v, pg8_bf16x2)); }
template <int ACT, bool ROT> struct EpiBf16 {
    static constexpr bool PERM = true, AFTER_DRAIN = false;
    bf16_t* O; int ldc; const float* rot;
    __device__ __forceinline__ void operator()(const f32x4 (&acc)[2][2][4][2], const Unit& u, int wr, int wc, int fr, int fq) const {
        const int row0 = u.pm * BM + wr * 64 + fr;
        const int col0 = u.pn * BM + wc * 32 + 8 * fq;
#pragma unroll
        for (int ai = 0; ai < 2; ++ai)
#pragma unroll
            for (int m = 0; m < 4; ++m) {
                const int row = row0 + ai * HALF + m * 16;
                bf16_t* rowp = O + (size_t)row * ldc + col0;
                f32x4 c0 = {1.f, 1.f, 1.f, 1.f}, c1 = c0, s0 = {0.f, 0.f, 0.f, 0.f}, s1 = s0;
                if (ROT) { if ((wc & 1) == 0 && fq < 2) { const int pos = row < 32768 ? (row & 16383) : (row & 2047); const f32x4* tp = (const f32x4*)(rot + (size_t)pos * 16);
                        c0 = tp[0]; c1 = tp[1]; s0 = tp[2]; s1 = tp[3]; if (fq == 0) { s0 = -s0; s1 = -s1; } } }
#pragma unroll
                for (int bj = 0; bj < 2; ++bj) { f32x4 v0 = acc[ai][bj][m][0], v1 = acc[ai][bj][m][1];
                    if (ACT == 2) {
#pragma unroll
                        for (int e = 0; e < 4; ++e) { const float a0 = fmaxf(v0[e], 0.f), a1 = fmaxf(v1[e], 0.f); v0[e] = a0 * a0; v1[e] = a1 * a1; } }
                    if (ROT) { if ((wc & 1) == 0) { f32x4 p0, p1;
#pragma unroll
                            for (int e = 0; e < 4; ++e) { p0[e] = __shfl_xor(v0[e], 16); p1[e] = __shfl_xor(v1[e], 16); }
                            v0 = v0 * c0 + p0 * s0; v1 = v1 * c1 + p1 * s1; } }
                    u32x4 w; w.x = cvt_pk_bf16(v0[0], v0[1]); w.y = cvt_pk_bf16(v0[2], v0[3]); w.z = cvt_pk_bf16(v1[0], v1[1]); w.w = cvt_pk_bf16(v1[2], v1[3]);
                    *(u32x4*)(rowp + bj * HALF) = w; } }
    }
};
struct EpiGateRes {
    static constexpr bool PERM = false, AFTER_DRAIN = false;
    const float* xp; const float* xs; float* out; const float* gate; int row_off;
    __device__ __forceinline__ void operator()(const f32x4 (&acc)[2][2][4][2], const Unit& u, int wr, int wc, int fr, int fq) const {
        const int grow0 = row_off + u.pm * BM;
        const int mb = grow0 < 32768 ? (grow0 >> 14) : 2 + ((grow0 - 32768) >> 11);
        const int col0 = u.pn * BM + wc * 32 + 4 * fq;
        const float* gp = gate + (size_t)mb * 6144 + col0;
        f32x4 gv[2][2];
#pragma unroll
        for (int bj = 0; bj < 2; ++bj)
#pragma unroll
            for (int n = 0; n < 2; ++n) gv[bj][n] = *(const f32x4*)(gp + bj * HALF + n * 16);
#pragma unroll
        for (int ai = 0; ai < 2; ++ai)
#pragma unroll
            for (int m = 0; m < 4; ++m) { const int row = grow0 + ai * HALF + wr * 64 + m * 16 + fr;
                const float* bp = (xp ? (row < 32768 ? xp + (size_t)row * 1024 : xs + (size_t)(row - 32768) * 1024) : out + (size_t)row * 1024) + col0;
                float* op = out + (size_t)row * 1024 + col0;
#pragma unroll
                for (int bj = 0; bj < 2; ++bj)
#pragma unroll
                    for (int n = 0; n < 2; ++n) { const f32x4 b = *(const f32x4*)(bp + bj * HALF + n * 16); *(f32x4*)(op + bj * HALF + n * 16) = b + gv[bj][n] * acc[ai][bj][m][n]; }
                if (m & 1) asm volatile("" ::: "memory"); }
    }
};
template <class Epi, class Sched, bool ALIGN_EPI = false, bool SP2 = false>
__device__ __forceinline__ void gemm_phase(PG8_LAS unsigned char* lds, const Gemm g, const Sched& S, const Epi& E) {
    int tid_ = threadIdx.x; asm volatile("" : "+v"(tid_));
    const int tid = tid_, wid = __builtin_amdgcn_readfirstlane(tid >> 6), lane = tid & 63, wr = wid >> 2, wc = wid & 3, fr = lane & 15, fq = lane >> 4;
    const int K = g.K, nt = K / BK;
    unsigned voffA[2], voffB[2];
#pragma unroll
    for (int i = 0; i < 2; ++i) { int R, C; stage_rc(tid * 16 + i * 8192, R, C); const int Rb = Epi::PERM ? ((R & ~31) + perm32(R & 31)) : R;
        voffA[i] = (unsigned)(R * K + C) * 2u; voffB[i] = (unsigned)(Rb * K + C) * 2u; }
    const size_t kstep = (size_t)(BK * 2);
    const size_t hstep = (size_t)HALF * K * 2;
    const size_t tstep = 2 * hstep;
    const unsigned ldsw = (unsigned)wid * 1024u;
    const int aoff = lds_byte(wr * 64 + fr, fq * 8), boff = lds_byte(wc * 32 + fr, fq * 8);
#define PG8_SA(b, h) (((b) * 2 + (h)) * HTB)
#define PG8_SB(b, h) ((4 + (b) * 2 + (h)) * HTB)
#define PG8_STAGE(bufoff, gbase, voff) do { _Pragma("unroll") for (int _i = 0; _i < 2; ++_i) \
        __builtin_amdgcn_global_load_lds((const unsigned*)((const char*)(gbase) + (voff)[_i]), (PG8_LAS unsigned*)(lds + (bufoff) + ldsw + _i * 8192), 16, 0, 0); } while (0)
#define PG8_LDA(dst, b, h) do { _Pragma("unroll") for (int m = 0; m < 4; ++m) _Pragma("unroll") for (int k = 0; k < 2; ++k) dst[m][k] = *(const PG8_LAS bf16x8*)(lds + PG8_SA(b, h) + aoff + m * 2048 + k * 1024); } while (0)
#define PG8_LDB(dst, b, h) do { _Pragma("unroll") for (int n = 0; n < 2; ++n) _Pragma("unroll") for (int k = 0; k < 2; ++k) dst[n][k] = *(const PG8_LAS bf16x8*)(lds + PG8_SB(b, h) + boff + n * 2048 + k * 1024); } while (0)
#define PG8_MMA(ai, bj, At, Bt) do { __builtin_amdgcn_s_setprio(1); _Pragma("unroll") for (int m = 0; m < 4; ++m) _Pragma("unroll") for (int n = 0; n < 2; ++n) _Pragma("unroll") for (int k = 0; k < 2; ++k) \
        acc[ai][bj][m][n] = __builtin_amdgcn_mfma_f32_16x16x32_bf16(Bt[n][k], At[m][k], acc[ai][bj][m][n], 0, 0, 0); __builtin_amdgcn_s_setprio(0); } while (0)
#define PG8_WAIT_V(n) asm volatile("s_waitcnt vmcnt(" #n ")" ::: "memory")
#define PG8_WAIT_L(n) asm volatile("s_waitcnt lgkmcnt(" #n ")" ::: "memory")
#define PG8_BAR __builtin_amdgcn_s_barrier()
#define PG8_SCHED __builtin_amdgcn_sched_barrier(0)
    Unit cur, nxt; int ui = 0;
    if (!S.next(0, cur)) return;
    f32x4 acc[2][2][4][2];
#pragma unroll
    for (int a = 0; a < 2; ++a)
#pragma unroll
        for (int b = 0; b < 2; ++b)
#pragma unroll
            for (int m = 0; m < 4; ++m)
#pragma unroll
                for (int n = 0; n < 2; ++n) acc[a][b][m][n] = (f32x4){0.f, 0.f, 0.f, 0.f};
    bf16x8 At[4][2], B0[2][2], B1[2][2];
    const char* cA = (const char*)g.A + (size_t)cur.pm * tstep; const char* cB = (const char*)g.Bt + (size_t)cur.pn * tstep;
    S.a_ready(cur);
    if constexpr (SP2) {
        PG8_STAGE(PG8_SB(0, 0), cB, voffB); PG8_STAGE(PG8_SB(0, 1), cB + hstep, voffB); PG8_STAGE(PG8_SA(0, 0), cA, voffA); PG8_STAGE(PG8_SA(0, 1), cA + hstep, voffA);
        if (wr == 1) PG8_BAR;
        PG8_WAIT_V(2); PG8_BAR;
        PG8_STAGE(PG8_SB(1, 0), cB + kstep, voffB); PG8_STAGE(PG8_SA(1, 0), cA + kstep, voffA); PG8_STAGE(PG8_SB(1, 1), cB + hstep + kstep, voffB);
        PG8_WAIT_V(6); PG8_BAR;
    } else {
        PG8_STAGE(PG8_SB(0, 0), cB, voffB); PG8_STAGE(PG8_SA(0, 0), cA, voffA); PG8_STAGE(PG8_SB(0, 1), cB + hstep, voffB); PG8_STAGE(PG8_SA(0, 1), cA + hstep, voffA);
        if (wr == 1) PG8_BAR;
        PG8_WAIT_V(4); PG8_BAR;
        PG8_STAGE(PG8_SB(1, 0), cB + kstep, voffB); PG8_STAGE(PG8_SA(1, 0), cA + kstep, voffA); PG8_STAGE(PG8_SB(1, 1), cB + hstep + kstep, voffB);
        PG8_WAIT_V(6); PG8_BAR;
    }
    for (;;) {
        const bool has_next = S.next(ui + 1, nxt);
        const char* nA = has_next ? (const char*)g.A + (size_t)nxt.pm * tstep : cA; const char* nB = has_next ? (const char*)g.Bt + (size_t)nxt.pn * tstep : cB;
        for (int t = 0; t < nt; t += 2) {
            const bool last = (t == nt - 2);
            const char* a1 = cA + (size_t)(t + 1) * kstep;
            const char* a2 = last ? nA : cA + (size_t)(t + 2) * kstep; const char* b2 = last ? nB : cB + (size_t)(t + 2) * kstep;
            const char* a3 = a2 + kstep; const char* b3 = b2 + kstep;
            if (last && has_next) S.a_ready(nxt);
            if constexpr (SP2) {
            PG8_LDB(B0, 0, 0); PG8_LDB(B1, 0, 1); PG8_SCHED; PG8_LDA(At, 0, 0); PG8_STAGE(PG8_SA(1, 1), a1 + hstep, voffA);
            PG8_WAIT_V(8); PG8_WAIT_L(0); PG8_BAR; PG8_MMA(0, 0, At, B0); PG8_MMA(0, 1, At, B1); PG8_BAR; PG8_SCHED;
            PG8_LDA(At, 0, 1); PG8_STAGE(PG8_SB(0, 0), b2, voffB); PG8_STAGE(PG8_SB(0, 1), b2 + hstep, voffB); PG8_STAGE(PG8_SA(0, 0), a2, voffA);
            PG8_WAIT_V(8); PG8_WAIT_L(0); PG8_BAR; PG8_MMA(1, 0, At, B0); PG8_MMA(1, 1, At, B1); PG8_BAR; PG8_SCHED;
            PG8_LDB(B0, 1, 0); PG8_LDB(B1, 1, 1); PG8_SCHED; PG8_LDA(At, 1, 0); PG8_STAGE(PG8_SA(0, 1), a2 + hstep, voffA);
            PG8_WAIT_V(8); PG8_WAIT_L(0); PG8_BAR; PG8_MMA(0, 0, At, B0); PG8_MMA(0, 1, At, B1); PG8_BAR; PG8_SCHED;
            PG8_LDA(At, 1, 1); PG8_STAGE(PG8_SB(1, 0), b3, voffB); PG8_STAGE(PG8_SB(1, 1), b3 + hstep, voffB); PG8_STAGE(PG8_SA(1, 0), a3, voffA);
            PG8_WAIT_V(8); PG8_WAIT_L(0); PG8_BAR; PG8_MMA(1, 0, At, B0); PG8_MMA(1, 1, At, B1); PG8_BAR; PG8_SCHED;
            } else {
            PG8_LDB(B0, 0, 0); PG8_SCHED; PG8_LDA(At, 0, 0); PG8_STAGE(PG8_SA(1, 1), a1 + hstep, voffA);
            PG8_WAIT_L(8); PG8_BAR; PG8_WAIT_L(0); PG8_MMA(0, 0, At, B0); PG8_BAR; PG8_SCHED;
            PG8_LDB(B1, 0, 1); PG8_STAGE(PG8_SB(0, 0), b2, voffB);
            PG8_BAR; PG8_WAIT_L(0); PG8_MMA(0, 1, At, B1); PG8_BAR;
            PG8_LDA(At, 0, 1); PG8_STAGE(PG8_SA(0, 0), a2, voffA);
            PG8_BAR; PG8_WAIT_L(0); PG8_MMA(1, 0, At, B0); PG8_BAR; PG8_SCHED;
            PG8_STAGE(PG8_SB(0, 1), b2 + hstep, voffB);
            PG8_WAIT_V(6); PG8_BAR; PG8_MMA(1, 1, At, B1); PG8_BAR;
            PG8_LDB(B0, 1, 0); PG8_SCHED; PG8_LDA(At, 1, 0); PG8_STAGE(PG8_SA(0, 1), a2 + hstep, voffA);
            PG8_WAIT_L(8); PG8_BAR; PG8_WAIT_L(0); PG8_MMA(0, 0, At, B0); PG8_BAR; PG8_SCHED;
            PG8_LDB(B1, 1, 1); PG8_STAGE(PG8_SB(1, 0), b3, voffB);
            PG8_BAR; PG8_WAIT_L(0); PG8_MMA(0, 1, At, B1); PG8_BAR;
            PG8_LDA(At, 1, 1); PG8_STAGE(PG8_SA(1, 0), a3, voffA);
            PG8_BAR; PG8_WAIT_L(0); PG8_MMA(1, 0, At, B0); PG8_BAR; PG8_SCHED;
            PG8_STAGE(PG8_SB(1, 1), b3 + hstep, voffB);
            PG8_WAIT_V(6); PG8_BAR; PG8_MMA(1, 1, At, B1); PG8_BAR;
            }
        }
        if constexpr (ALIGN_EPI) { if (wr == 0) PG8_BAR; }
        if constexpr (!Epi::AFTER_DRAIN) { E(acc, cur, wr, wc, fr, fq); S.done(cur); }
        if (!has_next) break;
#pragma unroll
        for (int a = 0; a < 2; ++a)
#pragma unroll
            for (int b = 0; b < 2; ++b)
#pragma unroll
                for (int m = 0; m < 4; ++m)
#pragma unroll
                    for (int n = 0; n < 2; ++n) acc[a][b][m][n] = (f32x4){0.f, 0.f, 0.f, 0.f};
        cur = nxt; cA = nA; cB = nB; ++ui;
        if constexpr (ALIGN_EPI) { if (wr == 1) PG8_BAR; }
    }
    PG8_WAIT_V(0);
    if constexpr (!ALIGN_EPI) { if (wr == 0) PG8_BAR; }
    PG8_BAR;
    if constexpr (Epi::AFTER_DRAIN) { E.fused(acc, cur, wr, wc, fr, fq, lds, wid, lane); S.done(cur); }
#undef PG8_SA
#undef PG8_SB
#undef PG8_STAGE
#undef PG8_LDA
#undef PG8_LDB
#undef PG8_MMA
#undef PG8_WAIT_V
#undef PG8_WAIT_L
#undef PG8_BAR
#undef PG8_SCHED
}
}
#ifndef PG8_SP2
#define PG8_SP2 true
#endif
#ifndef PG8_ALIGN
#define PG8_ALIGN true
#endif
constexpr int D = 1024, T_P = 32768, T_S = 65536, TT = T_P + T_S, L_P = 16384, L_S = 2048, NB_ROWS = 34, DIN = 3072, FF = 4096, HW = 512;
constexpr size_t MiB = 1u << 20;
constexpr size_t WS_WIN = 2 * MiB, WS_WOUT = 8 * MiB, WS_W1 = 10 * MiB, WS_W2 = 18 * MiB, WS_MOD = 26 * MiB, WS_ROT = 27 * MiB, WS_KRP = 28 * MiB, WS_KRS = 60 * MiB,
                 WS_XN = 64 * MiB, WS_UT = 256 * MiB, WS_QK = 544 * MiB, WS_VT = 736 * MiB, WS_YT = 832 * MiB, WS_END = 928 * MiB, WS_H = WS_UT;
constexpr int MLP_CHUNK = 49152, N_CHUNK = TT / MLP_CHUNK;
constexpr int LDS_BYTES = 147456;
constexpr int PH_P0 = 0, PH_XN1 = 1, PH_INPROJ = 2, PH_MIX = 3, PH_HNORM = 4, PH_OUTPROJ = 5, PH_XN2 = 6, PH_MLP0 = 7, PH_FINAL = PH_MLP0 + 2 * N_CHUNK, N_PHASES = PH_FINAL + 1;

#define GAS __attribute__((address_space(1)))
#define LAS __attribute__((address_space(3)))
typedef unsigned short bf16;
typedef unsigned v4u __attribute__((ext_vector_type(4)));
typedef unsigned u32x2 __attribute__((ext_vector_type(2)));
typedef float f32x4 __attribute__((ext_vector_type(4)));
typedef float f32x16 __attribute__((ext_vector_type(16)));
typedef short bf16x8 __attribute__((ext_vector_type(8)));
typedef short s16x4 __attribute__((ext_vector_type(4)));
typedef LAS unsigned char* ldsp;
#define LDS_WAIT() asm volatile("s_waitcnt lgkmcnt(0)" ::: "memory")
__device__ __forceinline__ unsigned f2bf(float f) { unsigned u = __builtin_bit_cast(unsigned, f); return (u + 0x7fffu + ((u >> 16) & 1u)) >> 16; }
__device__ __forceinline__ unsigned pk2(float lo, float hi) { return f2bf(lo) | (f2bf(hi) << 16); }
__device__ __forceinline__ float bflo(unsigned w) { return __builtin_bit_cast(float, w << 16); }
__device__ __forceinline__ float bfhi(unsigned w) { return __builtin_bit_cast(float, w & 0xffff0000u); }
__device__ __forceinline__ float bf2f(unsigned short b) { return __builtin_bit_cast(float, ((unsigned)b) << 16); }
__device__ __forceinline__ float wave_sum(float v) {
#pragma unroll
    for (int o = 1; o < 64; o <<= 1) v += __shfl_xor(v, o);
    return v;
}
__device__ __forceinline__ float rdlane(float v, int i) { return __builtin_bit_cast(float, __builtin_amdgcn_readlane(__builtin_bit_cast(int, v), i)); }
__device__ __forceinline__ int batch_of_row(int row) { return row < T_P ? (row >> 14) : 2 + ((row - T_P) >> 11); }

struct Args { const float* in[30]; float* out; unsigned char* ws; int ph_lo, ph_hi; };

__device__ __forceinline__ void p0_transpose_item(const float* W, int K, int N, bf16* WT, int row_off, LAS float* scr, int item, int lane) {
    const int nblk = N / 32, kb = item / nblk, nb = item % nblk, k0 = 64 * kb, n0 = 32 * nb;
    float tv[32];
#pragma unroll
    for (int i = 0; i < 32; ++i) tv[i] = W[(size_t)(k0 + 2 * i + (lane >> 5)) * N + n0 + (lane & 31)];
#pragma unroll
    for (int i = 0; i < 32; ++i) scr[(2 * i + (lane >> 5)) * 33 + (lane & 31)] = tv[i];
    LDS_WAIT(); asm volatile("" ::: "memory");
    const int c = lane & 7;
#pragma unroll
    for (int j = 0; j < 4; ++j) { const int n = (lane >> 3) + 8 * j; const LAS float* s = scr + (8 * c) * 33 + n;
        v4u o; o.x = pk2(s[0 * 33], s[1 * 33]); o.y = pk2(s[2 * 33], s[3 * 33]); o.z = pk2(s[4 * 33], s[5 * 33]); o.w = pk2(s[6 * 33], s[7 * 33]);
        *(GAS v4u*)(WT + (size_t)(row_off + n0 + n) * K + k0 + 8 * c) = o; }
    LDS_WAIT(); asm volatile("" ::: "memory");
}
__device__ __forceinline__ void adaln_item(ldsp lds, const Args& a, float* MOD, int item, int tid, int wid, int lane) {
    LAS float* sc = (LAS float*)lds;
    const float* cp = a.in[2]; const float* cs = a.in[3];
    for (int idx = tid; idx < NB_ROWS * D; idx += 512) { const int r = idx >> 10, k = idx & 1023; const float x = r < 2 ? cp[r * D + k] : cs[(r - 2) * D + k]; sc[idx] = x / (1.f + expf(-x)); }
    __syncthreads();
    const int n0 = item * 64; const float* W = a.in[4] + n0 + lane;
    float acc[NB_ROWS];
#pragma unroll
    for (int r = 0; r < NB_ROWS; ++r) acc[r] = 0.f;
    for (int k = wid * 128; k < wid * 128 + 128; k += 4) {
        const float w0 = W[(size_t)k * 6144], w1 = W[(size_t)(k + 1) * 6144], w2 = W[(size_t)(k + 2) * 6144], w3 = W[(size_t)(k + 3) * 6144];
#pragma unroll
        for (int r = 0; r < NB_ROWS; ++r) { const f32x4 s = *(const LAS f32x4*)(sc + r * D + k); acc[r] += (s.x * w0 + s.y * w1) + (s.z * w2 + s.w * w3); }
    }
    __syncthreads();
    LAS float* part = (LAS float*)lds;
#pragma unroll
    for (int r = 0; r < NB_ROWS; ++r) part[(wid * NB_ROWS + r) * 64 + lane] = acc[r];
    __syncthreads();
    for (int r = wid; r < NB_ROWS; r += 8) { float s = a.in[5][n0 + lane];
#pragma unroll
        for (int p = 0; p < 8; ++p) s += part[(p * NB_ROWS + r) * 64 + lane];
        MOD[(size_t)r * 6144 + n0 + lane] = s; }
    __syncthreads();
}

__device__ __forceinline__ int crow16(int r, int hi) { return (r & 3) + 8 * (r >> 2) + 4 * hi; }
__device__ __forceinline__ void filter_item32(const Args& a, int L, bf16* KR, int t0, int np0, int npn, int lane) {
    const float *w1 = a.in[10], *b1 = a.in[11], *w2 = a.in[12], *b2 = a.in[13], *w3 = a.in[14], *b3 = a.in[15], *w4 = a.in[16], *fq = a.in[17];
    const int n = lane & 31, hi = lane >> 5, t = t0 + n;
    const float tt = (float)t * (1.0f / (float)(L - 1)), w = 6.283185307179586f * (float)t / (float)L;
    f32x16 h0 = {}, h1 = {};
    {
        float cv[8], sv[8];
#pragma unroll
        for (int k = 0; k < 8; ++k) { const float f = 1e-4f + (float)(k + 8 * hi) * ((15.0f - 1e-4f) / 15.0f); float s, c; sincosf(f * w, &s, &c); cv[k] = c; sv[k] = -s; }
#pragma unroll
        for (int kk = 0; kk < 17; ++kk) {
            const int urow = kk < 8 ? 1 + kk : (kk < 16 ? 17 + (kk - 8) : 0);
            const float zb = kk < 8 ? cv[kk & 7] : (kk < 16 ? sv[kk & 7] : (hi == 0 ? tt : 0.f));
            const float* ub = w1 + urow * 64; const int lo1 = kk < 16 ? 8 * hi * 64 + n : n;
            const float a0 = ub[lo1], a1 = ub[lo1 + 32];
            h0 = __builtin_amdgcn_mfma_f32_32x32x2f32(a0, zb, h0, 0, 0, 0); h1 = __builtin_amdgcn_mfma_f32_32x32x2f32(a1, zb, h1, 0, 0, 0);
        }
#pragma unroll
        for (int r = 0; r < 16; ++r) { const int j = crow16(r, hi); h0[r] = sinf(fq[j] * (h0[r] + b1[j])); h1[r] = sinf(fq[32 + j] * (h1[r] + b1[32 + j])); }
    }
#pragma unroll
    for (int layer = 0; layer < 2; ++layer) {
        const float* W = layer ? w3 : w2; const float* bb = layer ? b3 : b2;
        f32x16 g0 = {}, g1 = {}; const int lo2 = 4 * hi * 64 + n;
#pragma unroll
        for (int kk = 0; kk < 32; ++kk) {
            const float* ub = W + (32 * (kk >> 4) + crow16(kk & 15, 0)) * 64;
            const float zb = kk < 16 ? h0[kk & 15] : h1[kk & 15];
            const float a0 = ub[lo2], a1 = ub[lo2 + 32];
            g0 = __builtin_amdgcn_mfma_f32_32x32x2f32(a0, zb, g0, 0, 0, 0); g1 = __builtin_amdgcn_mfma_f32_32x32x2f32(a1, zb, g1, 0, 0, 0);
        }
#pragma unroll
        for (int r = 0; r < 16; ++r) { const int j = crow16(r, hi); h0[r] = sinf(fq[j] * (g0[r] + bb[j])); h1[r] = sinf(fq[32 + j] * (g1[r] + bb[32 + j])); }
    }
    const float dmin = -3.0701134573253943f, dmax = -15.350567286626972f;
#pragma unroll 1
    for (int np = np0; np < np0 + npn; ++np) {
        f32x16 of = {}, ob = {};
        const float* wr = w4 + 32 * np; const int lo4 = 4 * hi * 1024 + n;
#pragma unroll
        for (int kk = 0; kk < 32; ++kk) {
            const float* ub = wr + (32 * (kk >> 4) + crow16(kk & 15, 0)) * 1024;
            const float zb = kk < 16 ? h0[kk & 15] : h1[kk & 15];
            const float af = ub[lo4], ab = ub[lo4 + 512];
            of = __builtin_amdgcn_mfma_f32_32x32x2f32(af, zb, of, 0, 0, 0); ob = __builtin_amdgcn_mfma_f32_32x32x2f32(ab, zb, ob, 0, 0, 0);
        }
#pragma unroll
        for (int r = 0; r < 16; ++r) { const int c = 32 * np + crow16(r, hi); const float ad = -(dmin + (float)c * ((dmax - dmin) / 511.0f));
            const float dec = expf(-tt * ad); bf16* kr = KR + (size_t)c * (2 * L);
            if (t == 0) { kr[L] = (bf16)f2bf(of[r] + ob[r]); kr[0] = 0; } else { kr[L - t] = (bf16)f2bf(of[r] * dec); kr[L + t] = (bf16)f2bf(ob[r] * dec); } }
    }
}

template <int MODE> __device__ __forceinline__ void norm_row(const float* xrow, const float* nw, const float* sc, const float* sh, bf16* orow, float* frow, float eps, int lane) {
    const f32x4* xr = (const f32x4*)xrow + lane;
    f32x4 v[4]; float s = 0.f;
#pragma unroll
    for (int j = 0; j < 4; ++j) { v[j] = xr[64 * j]; s += (v[j].x * v[j].x + v[j].y * v[j].y) + (v[j].z * v[j].z + v[j].w * v[j].w); }
    const float r = 1.f / sqrtf(wave_sum(s) * (1.f / D) + eps);
#pragma unroll
    for (int j = 0; j < 4; ++j) { const f32x4 w = ((const f32x4*)nw)[64 * j + lane]; f32x4 y = v[j] * r * w;
        if (MODE == 0) { const f32x4 c = ((const f32x4*)sc)[64 * j + lane], h = ((const f32x4*)sh)[64 * j + lane]; y = y * (c + 1.f) + h;
            u32x2 o; o.x = pk2(y.x, y.y); o.y = pk2(y.z, y.w); ((u32x2*)orow)[64 * j + lane] = o; }
        else ((f32x4*)frow)[64 * j + lane] = y; }
}
template <int MODE> __device__ __forceinline__ void norm_row2(const float* xa, const float* xb, const float* nw, const float* sca, const float* sha, const float* scb, const float* shb,
                                                              bf16* oa, bf16* ob, float* fa_, float* fb_, float eps, int lane) {
    const f32x4* pa = (const f32x4*)xa + lane; const f32x4* pb = (const f32x4*)xb + lane;
    f32x4 va[4], vb[4]; float s0 = 0.f, s1 = 0.f;
#pragma unroll
    for (int j = 0; j < 4; ++j) { va[j] = pa[64 * j]; vb[j] = pb[64 * j]; }
#pragma unroll
    for (int j = 0; j < 4; ++j) { s0 += (va[j].x * va[j].x + va[j].y * va[j].y) + (va[j].z * va[j].z + va[j].w * va[j].w); s1 += (vb[j].x * vb[j].x + vb[j].y * vb[j].y) + (vb[j].z * vb[j].z + vb[j].w * vb[j].w); }
#pragma unroll
    for (int o = 1; o < 64; o <<= 1) { s0 += __shfl_xor(s0, o); s1 += __shfl_xor(s1, o); }
    const float r0 = 1.f / sqrtf(s0 * (1.f / D) + eps), r1 = 1.f / sqrtf(s1 * (1.f / D) + eps);
#pragma unroll
    for (int j = 0; j < 4; ++j) { const f32x4 w = ((const f32x4*)nw)[64 * j + lane]; f32x4 ya = va[j] * r0 * w, yb = vb[j] * r1 * w;
        if (MODE == 0) { const f32x4 ca = ((const f32x4*)sca)[64 * j + lane], ha = ((const f32x4*)sha)[64 * j + lane], cb = ((const f32x4*)scb)[64 * j + lane], hb = ((const f32x4*)shb)[64 * j + lane];
            ya = ya * (ca + 1.f) + ha; yb = yb * (cb + 1.f) + hb;
            u32x2 o; o.x = pk2(ya.x, ya.y); o.y = pk2(ya.z, ya.w); ((u32x2*)oa)[64 * j + lane] = o; o.x = pk2(yb.x, yb.y); o.y = pk2(yb.z, yb.w); ((u32x2*)ob)[64 * j + lane] = o; }
        else { ((f32x4*)fa_)[64 * j + lane] = ya; ((f32x4*)fb_)[64 * j + lane] = yb; } }
}
__device__ __forceinline__ void hyena_unit(ldsp lds, const Args& a, const bf16* UT, const bf16* KRP, const bf16* KRS, bf16* YT, int unit, int tid, int wid, int lane) {
    const bool pr = unit < HW;
    const int c = pr ? unit : ((unit - HW) >> 1), half = pr ? 0 : ((unit - HW) & 1);
    const int L = pr ? L_P : L_S, Nb = L >> 5, nseq = pr ? 2 : 16;
    const int SP = (Nb + 64) * 64;
    const int HY_SOFF = 4 * L + 64;
    const bf16* KR = (pr ? KRP : KRS) + (size_t)c * (2 * L);
    { const int nz = (nseq * SP) >> 4; for (int i = tid; i < nz; i += 512) *(LAS v4u*)(lds + HY_SOFF + i * 16) = (v4u){0u, 0u, 0u, 0u};
      if (tid < 4) *(LAS v4u*)(lds + 4 * L + tid * 16) = (v4u){0u, 0u, 0u, 0u}; }
    { const int nc = (4 * L) >> 4; for (int i = tid; i < nc; i += 512) *(LAS v4u*)(lds + i * 16) = *(const v4u*)((const char*)KR + (size_t)i * 16); }
    __syncthreads();
    const float* cw = a.in[8]; const float* cb = a.in[9];
    {
        const float a0 = cw[HW + c], a1 = cw[1536 + HW + c], a2 = cw[3072 + HW + c], ab = cb[HW + c];
        const float v0 = cw[2 * HW + c], v1 = cw[1536 + 2 * HW + c], v2 = cw[3072 + 2 * HW + c], vb = cb[2 * HW + c];
        const int gps = L >> 3, total = nseq * gps;
        (void)total;
#pragma unroll
        for (int bt = 0; bt < 2; ++bt) {
            v4u r1[4], r2[4]; unsigned short h1m[4], h1p[4], h2m[4], h2p[4]; int tq[4], sq_[4];
#pragma unroll
            for (int q = 0; q < 4; ++q) {
                const int g = tid + 512 * (4 * bt + q); const int seq = g / gps, tg = g - seq * gps, t = tg << 3; tq[q] = t; sq_[q] = seq;
                const size_t tok = (size_t)(pr ? seq * L_P : T_P + (half * 16 + seq) * L_S) + t;
                const bf16* p1 = UT + (size_t)(HW + c) * TT + tok; const bf16* p2 = UT + (size_t)(2 * HW + c) * TT + tok;
                r1[q] = *(const v4u*)p1; r2[q] = *(const v4u*)p2;
                const int im = t > 0 ? -1 : 0, ip = t + 8 < L ? 8 : 7;
                h1m[q] = p1[im]; h2m[q] = p2[im]; h1p[q] = p1[ip]; h2p[q] = p2[ip];
            }
#pragma unroll
            for (int q = 0; q < 4; ++q) {
                const int t = tq[q], seq = sq_[q]; const v4u ra = r1[q], rb2 = r2[q];
                float x[10], y[10];
                x[0] = t > 0 ? bf2f(h1m[q]) : 0.f; y[0] = t > 0 ? bf2f(h2m[q]) : 0.f;
                x[9] = t + 8 < L ? bf2f(h1p[q]) : 0.f; y[9] = t + 8 < L ? bf2f(h2p[q]) : 0.f;
                x[1] = bflo(ra.x); x[2] = bfhi(ra.x); x[3] = bflo(ra.y); x[4] = bfhi(ra.y); x[5] = bflo(ra.z); x[6] = bfhi(ra.z); x[7] = bflo(ra.w); x[8] = bfhi(ra.w);
                y[1] = bflo(rb2.x); y[2] = bfhi(rb2.x); y[3] = bflo(rb2.y); y[4] = bfhi(rb2.y); y[5] = bflo(rb2.z); y[6] = bfhi(rb2.z); y[7] = bflo(rb2.w); y[8] = bfhi(rb2.w);
                float sv[8];
#pragma unroll
                for (int e = 0; e < 8; ++e) sv[e] = (a0 * x[e] + a1 * x[e + 1] + a2 * x[e + 2] + ab) * (v0 * y[e] + v1 * y[e + 1] + v2 * y[e + 2] + vb);
                v4u o; o.x = pk2(sv[0], sv[1]); o.y = pk2(sv[2], sv[3]); o.z = pk2(sv[4], sv[5]); o.w = pk2(sv[6], sv[7]);
                const int r = 32 + (t >> 5), ci = (t & 31) >> 3;
                *(LAS v4u*)(lds + HY_SOFF + seq * SP + r * 64 + ((ci ^ ((r >> 2) & 3)) << 4)) = o;
            }
        }
    }
    __syncthreads();
    const int n = lane & 31, hi = lane >> 5;
    const int i0 = pr ? 64 * wid : 0, sq0 = pr ? 0 : 2 * wid, sq1 = sq0 + 1;
    const unsigned sb0 = HY_SOFF + sq0 * SP, sb1 = HY_SOFF + sq1 * SP;
    f32x16 acc00 = {}, acc01 = {}, acc10 = {}, acc11 = {};
    unsigned Xd[2][5], Yd[2][5]; v4u Xb0[2][2], Xb1[2][2], Yb0[2][2], Yb1[2][2];
    const unsigned hy_sh = (unsigned)(n & 1) << 4, hy_ab = (unsigned)(((L - n + 8 * hi) >> 1) * 4); const int hy_rb = 32 + i0 + n;
#define HY_LOAD(dd, T0, T1, P) do { const int dq_ = (dd); \
        const LAS unsigned* fp = (const LAS unsigned*)(lds + (hy_ab - 64u * (unsigned)dq_)); \
        _Pragma("unroll") for (int kk = 0; kk < 2; ++kk) { P##d[kk][0] = fp[8 * kk]; P##d[kk][1] = fp[8 * kk + 1]; P##d[kk][2] = fp[8 * kk + 2]; P##d[kk][3] = fp[8 * kk + 3]; P##d[kk][4] = fp[8 * kk + 4]; } \
        const int r0_ = hy_rb - dq_; const unsigned off0_ = ((unsigned)r0_ << 6) + ((((unsigned)r0_ >> 2) & 3u) ^ (unsigned)hi) * 16u, off1_ = off0_ ^ 32u; \
        if (T0) { P##b0[0][0] = *(const LAS v4u*)(lds + sb0 + off0_); P##b0[0][1] = *(const LAS v4u*)(lds + sb1 + off0_); P##b0[1][0] = *(const LAS v4u*)(lds + sb0 + off1_); P##b0[1][1] = *(const LAS v4u*)(lds + sb1 + off1_); } \
        if (T1) { P##b1[0][0] = *(const LAS v4u*)(lds + sb0 + off0_ + 2048); P##b1[0][1] = *(const LAS v4u*)(lds + sb1 + off0_ + 2048); P##b1[1][0] = *(const LAS v4u*)(lds + sb0 + off1_ + 2048); P##b1[1][1] = *(const LAS v4u*)(lds + sb1 + off1_ + 2048); } } while (0)
#define HY_COMP(T0, T1, P) do { _Pragma("unroll") for (int kk = 0; kk < 2; ++kk) { const unsigned sh = hy_sh; v4u aw; \
        aw.x = __builtin_amdgcn_alignbit(P##d[kk][1], P##d[kk][0], sh); aw.y = __builtin_amdgcn_alignbit(P##d[kk][2], P##d[kk][1], sh); \
        aw.z = __builtin_amdgcn_alignbit(P##d[kk][3], P##d[kk][2], sh); aw.w = __builtin_amdgcn_alignbit(P##d[kk][4], P##d[kk][3], sh); \
        const bf16x8 A = __builtin_bit_cast(bf16x8, aw); \
        if (T0) { acc00 = __builtin_amdgcn_mfma_f32_32x32x16_bf16(A, __builtin_bit_cast(bf16x8, P##b0[kk][0]), acc00, 0, 0, 0); \
                  acc01 = __builtin_amdgcn_mfma_f32_32x32x16_bf16(A, __builtin_bit_cast(bf16x8, P##b0[kk][1]), acc01, 0, 0, 0); } \
        if (T1) { acc10 = __builtin_amdgcn_mfma_f32_32x32x16_bf16(A, __builtin_bit_cast(bf16x8, P##b1[kk][0]), acc10, 0, 0, 0); \
                  acc11 = __builtin_amdgcn_mfma_f32_32x32x16_bf16(A, __builtin_bit_cast(bf16x8, P##b1[kk][1]), acc11, 0, 0, 0); } } } while (0)
#define HY_SB() __builtin_amdgcn_sched_barrier(0)
#define HY_SEG(dlo, dhi, T0, T1) do { int d = (dlo); const int dh_ = (dhi); HY_LOAD(d, T0, T1, X); HY_SB(); \
        for (; d + 1 <= dh_; d += 2) { HY_LOAD(d + 1, T0, T1, Y); HY_SB(); HY_COMP(T0, T1, X); HY_SB(); \
            HY_LOAD((d + 2 <= dh_ ? d + 2 : dh_), T0, T1, X); HY_SB(); HY_COMP(T0, T1, Y); HY_SB(); } \
        if (d == dh_) { HY_COMP(T0, T1, X); HY_SB(); } } while (0)
    HY_SEG(i0 - Nb + 1, i0 + 32 - Nb, true, false);
    HY_SEG(i0 + 33 - Nb, i0 + 31, true, true);
    HY_SEG(i0 + 32, i0 + 63, false, true);
#undef HY_LOAD
#undef HY_COMP
#undef HY_SB
#undef HY_SEG
    {
        const float a0 = cw[c], a1 = cw[1536 + c], a2 = cw[3072 + c], ab = cb[c], hb = a.in[18][c];
#pragma unroll
        for (int ts = 0; ts < 4; ++ts) {
            const int tile = ts >> 1, sl = ts & 1; const f32x16 acc = ts == 0 ? acc00 : (ts == 1 ? acc01 : (ts == 2 ? acc10 : acc11));
            const int sq = sl ? sq1 : sq0; const int i = i0 + 32 * tile + n;
            const size_t tokb = (size_t)(pr ? sq * L_P : T_P + (half * 16 + sq) * L_S);
            const bf16* u0 = UT + (size_t)c * TT + tokb; bf16* yo = YT + (size_t)c * TT + tokb;
#pragma unroll
            for (int g4 = 0; g4 < 4; ++g4) {
                const int aa = 8 * g4 + 4 * hi, t = 32 * i + aa;
                const u32x2 ru = *(const u32x2*)(u0 + t);
                float x[6]; x[0] = t > 0 ? bf2f(u0[t - 1]) : 0.f; x[5] = t + 4 < L ? bf2f(u0[t + 4]) : 0.f;
                x[1] = bflo(ru.x); x[2] = bfhi(ru.x); x[3] = bflo(ru.y); x[4] = bfhi(ru.y);
                const int r = 32 + i, ci = aa >> 3;
                const u32x2 rs = *(const LAS u32x2*)(lds + HY_SOFF + sq * SP + r * 64 + ((ci ^ ((r >> 2) & 3)) << 4) + (aa & 7) * 2);
                const float s0 = bflo(rs.x), s1 = bfhi(rs.x), s2 = bflo(rs.y), s3 = bfhi(rs.y);
                const float y0 = (a0 * x[0] + a1 * x[1] + a2 * x[2] + ab) * (acc[4 * g4 + 0] + s0 * hb);
                const float y1 = (a0 * x[1] + a1 * x[2] + a2 * x[3] + ab) * (acc[4 * g4 + 1] + s1 * hb);
                const float y2 = (a0 * x[2] + a1 * x[3] + a2 * x[4] + ab) * (acc[4 * g4 + 2] + s2 * hb);
                const float y3 = (a0 * x[3] + a1 * x[4] + a2 * x[5] + ab) * (acc[4 * g4 + 3] + s3 * hb);
                u32x2 o; o.x = pk2(y0, y1); o.y = pk2(y2, y3); *(u32x2*)(yo + t) = o;
            }
        }
    }
    __syncthreads();
}

__device__ __forceinline__ void hnorm_phase(ldsp lds, const Args& a, const bf16* YT, bf16* MIX, int bx, int G, int tid, int wid, int lane) {
    LAS unsigned* tile = (LAS unsigned*)lds;
    const float* hw = a.in[19];
    constexpr int NIT = TT / 64;
    v4u pre[8];
    int it = bx;
    if (it < NIT) {
#pragma unroll
        for (int q = 0; q < 8; ++q) { const int idx = tid + 512 * q, c = idx >> 3, k = idx & 7; pre[q] = *(const v4u*)(YT + (size_t)c * TT + it * 64 + 8 * k); } }
    for (; it < NIT; it += G) {
        const int tok0 = it * 64;
#pragma unroll
        for (int q = 0; q < 8; ++q) { const int idx = tid + 512 * q, c = idx >> 3, k = idx & 7; LAS unsigned* p = tile + c * 33 + 4 * k; p[0] = pre[q].x; p[1] = pre[q].y; p[2] = pre[q].z; p[3] = pre[q].w; }
        __syncthreads();
        if (it + G < NIT) {
#pragma unroll
            for (int q = 0; q < 8; ++q) { const int idx = tid + 512 * q, c = idx >> 3, k = idx & 7; pre[q] = *(const v4u*)(YT + (size_t)c * TT + (it + G) * 64 + 8 * k); } }
        for (int tt = wid * 8; tt < wid * 8 + 8; ++tt) {
            float v[8]; float ss = 0.f;
#pragma unroll
            for (int e = 0; e < 8; ++e) { const unsigned w = tile[(e * 64 + lane) * 33 + (tt >> 1)]; v[e] = (tt & 1) ? bfhi(w) : bflo(w); ss += v[e] * v[e]; }
            const float r = 1.f / sqrtf(wave_sum(ss) * (1.f / HW) + 1e-6f);
            bf16* orow = MIX + (size_t)(tok0 + tt) * D;
#pragma unroll
            for (int e = 0; e < 8; ++e) orow[e * 64 + lane] = (bf16)f2bf(v[e] * r * hw[e * 64 + lane]);
        }
        __syncthreads();
    }
}

constexpr int AT_KP = 272, AT_VP = 144, AT_KB = 64 * AT_KP, AT_VB = 128 * AT_VP, AT_V0 = 2 * AT_KB, AT_EX = 2 * AT_KB + 2 * AT_VB, AT_EXP = 132;
typedef float f32x2 __attribute__((ext_vector_type(2)));
typedef __bf16 at_bf16x2 __attribute__((ext_vector_type(2)));
__device__ __forceinline__ unsigned at_cvtpk(f32x2 v) { return __builtin_bit_cast(unsigned, __builtin_convertvector(v, at_bf16x2)); }
#define AT_BAR() do { asm volatile("s_waitcnt lgkmcnt(0)" ::: "memory"); __builtin_amdgcn_s_barrier(); asm volatile("" ::: "memory"); } while (0)
__device__ __forceinline__ void attn_unit(ldsp lds, const bf16* QK, const bf16* VT, bf16* MIX, const float* subln, float lam, int tokbase, int L, int h, int qb, int tid, int wid, int lane) {
    const int n = lane & 31, hi = lane >> 5, j = wid >> 2, g = wid & 3;
    const int q0 = qb * 128 + g * 32;
    bf16x8 qf[4];
    { const bf16* qp = QK + (size_t)(tokbase + q0 + n) * D + (2 * h + j) * 64 + hi * 8;
#pragma unroll
      for (int kk = 0; kk < 4; ++kk) qf[kk] = *(const bf16x8*)(qp + 16 * kk); }
#define qf_(kk) qf[kk]
    const int kkey0 = tid >> 4, kc = tid & 15;
    const int vdv0 = tid >> 3, vc = tid & 7;
    const __amdgpu_buffer_rsrc_t rk = __builtin_amdgcn_make_buffer_rsrc((void*)(QK + (size_t)tokbase * D), (short)0, L * 2048, 0x00020000);
    const __amdgpu_buffer_rsrc_t rv = __builtin_amdgcn_make_buffer_rsrc((void*)(VT + (size_t)(h * 128) * TT + tokbase), (short)0, 128 * TT * 2, 0x00020000);
    const int kvo0 = kkey0 * 2048 + (512 + h * 128 + kc * 8) * 2, kvo1 = kvo0 + 32 * 2048, vvo0 = vdv0 * (TT * 2) + vc * 16, vvo1 = vvo0 + 64 * (TT * 2);
    const unsigned klo = kkey0 * AT_KP + kc * 16, vlo = AT_V0 + vdv0 * AT_VP + (vc >> 1) * 32 + (vc & 1) * 8;
    const int NT = L >> 6;
    v4u kr0, kr1, vr0, vr1;
#define AT_BL(r, vo, so) __builtin_bit_cast(v4u, __builtin_amdgcn_raw_buffer_load_b128(r, vo, so, 0))
#define AT_LDK(t) do { const int so_ = (t) * 131072; kr0 = AT_BL(rk, kvo0, so_); kr1 = AT_BL(rk, kvo1, so_); } while (0)
#define AT_LDV(t) do { const int so_ = (t) * 128; vr0 = AT_BL(rv, vvo0, so_); vr1 = AT_BL(rv, vvo1, so_); } while (0)
#define AT_WRK(t) do { const unsigned bo = ((t) & 1) * AT_KB; *(LAS v4u*)(lds + bo + klo) = kr0; *(LAS v4u*)(lds + bo + klo + 32 * AT_KP) = kr1; } while (0)
#define AT_WRV(t) do { const unsigned bo = ((t) & 1) * AT_VB; *(LAS u32x2*)(lds + bo + vlo) = (u32x2){vr0.x, vr0.y}; *(LAS u32x2*)(lds + bo + vlo + 16) = (u32x2){vr0.z, vr0.w}; \
        *(LAS u32x2*)(lds + bo + vlo + 64 * AT_VP) = (u32x2){vr1.x, vr1.y}; *(LAS u32x2*)(lds + bo + vlo + 64 * AT_VP + 16) = (u32x2){vr1.z, vr1.w}; } while (0)
#define AT_MF(a, b, c) __builtin_amdgcn_mfma_f32_32x32x16_bf16(a, b, c, 0, 0, 0)
#define AT_B8(x) __builtin_bit_cast(bf16x8, x)
    AT_LDK(0); vr0 = AT_BL(rk, kvo0, 131072); vr1 = AT_BL(rk, kvo1, 131072);
    AT_WRK(0); *(LAS v4u*)(lds + AT_KB + klo) = vr0; *(LAS v4u*)(lds + AT_KB + klo + 32 * AT_KP) = vr1;
    for (int i = tid; i < AT_VB / 16; i += 512) *(LAS v4u*)(lds + AT_V0 + AT_VB + i * 16) = (v4u){0u, 0u, 0u, 0u};
    AT_BAR();
    f32x16 o[4] = {}; float m_reg = -1e30f, l_reg = 0.f;
    constexpr float C = 0.125f * 1.4426950408889634f;
    const unsigned kro = n * AT_KP + j * 128 + hi * 16, vro = AT_V0 + n * AT_VP + hi * 16;
    f32x16 sa0, sa1, sb0, sb1; bf16x8 pba[4] = {}, pbb[4] = {};
    {
        const unsigned kb = kro;
        sa0 = AT_MF(*(const LAS bf16x8*)(lds + kb), qf_(0), (f32x16){}); sa1 = AT_MF(*(const LAS bf16x8*)(lds + kb + 32 * AT_KP), qf_(0), (f32x16){});
#pragma unroll
        for (int kk = 1; kk < 4; ++kk) { sa0 = AT_MF(*(const LAS bf16x8*)(lds + kb + kk * 32), qf_(kk), sa0); sa1 = AT_MF(*(const LAS bf16x8*)(lds + kb + 32 * AT_KP + kk * 32), qf_(kk), sa1); }
    }
#define AT_SB() __builtin_amdgcn_sched_barrier(0)
#define AT_SPV(c, SP0, SP1) ((((c) >> 2) < 2) ? (f32x2){SP0[8 * (((c) >> 2) & 1) + 2 * ((c) & 3)], SP0[8 * (((c) >> 2) & 1) + 2 * ((c) & 3) + 1]} : (f32x2){SP1[8 * (((c) >> 2) & 1) + 2 * ((c) & 3)], SP1[8 * (((c) >> 2) & 1) + 2 * ((c) & 3) + 1]})
#define AT_FMA(c, SP0, SP1) do { const f32x2 sp_ = AT_SPV(c, SP0, SP1); float a_ = fmaf(sp_.x, C, mC_); asm volatile("" : "+v"(a_)); const float b_ = fmaf(sp_.y, C, mC_); xs_[(c) & 1] = (f32x2){a_, b_}; } while (0)
#define AT_EXP(c) do { ev_[(c) & 1].x = __builtin_amdgcn_exp2f(xs_[(c) & 1].x); ev_[(c) & 1].y = __builtin_amdgcn_exp2f(xs_[(c) & 1].y); } while (0)
#define AT_ACC(c) do { ps0_ += ev_[(c) & 1].x; ps1_ += ev_[(c) & 1].y; asm volatile("" : "+v"(ps0_), "+v"(ps1_)); wn_[(c) >> 2][(c) & 3] = at_cvtpk(ev_[(c) & 1]); } while (0)
#define AT_VF(dt, s_) (*(const LAS v4u*)(lds + vb_ + (dt) * 32 * AT_VP + (s_) * 32))
#define AT_KF(kk, hf) (*(const LAS v4u*)(lds + kb_ + (hf) * 32 * AT_KP + (kk) * 32))
#define AT_ITER(t, SP0, SP1, SQ0, SQ1, PBO, PBN) do { \
        const unsigned kb_ = (((t) + 1) & 1) * AT_KB + kro, vb_ = (((t) + 1) & 1) * AT_VB + vro; \
        v4u fa[4], fb[4], wn_[4]; f32x2 xs_[2], ev_[2]; float ps0_ = 0.f, ps1_ = 0.f; \
        fa[0] = AT_VF(0, 0); fa[1] = AT_VF(0, 1); fa[2] = AT_VF(0, 2); fa[3] = AT_VF(0, 3); \
        float pmax_ = fmaxf(SP0[0], SP1[0]); \
        _Pragma("unroll") for (int r = 1; r < 16; ++r) pmax_ = fmaxf(fmaxf(pmax_, SP0[r]), SP1[r]); \
        pmax_ = fmaxf(pmax_, __shfl_xor(pmax_, 32)); \
        const float mn_ = fmaxf(m_reg, pmax_), alpha_ = __builtin_amdgcn_exp2f((m_reg - mn_) * C), mC_ = -mn_ * C; \
        const bool need_ = !__all(pmax_ <= m_reg); \
        AT_FMA(0, SP0, SP1); \
        AT_SB(); \
        o[0] = AT_MF(AT_B8(fa[0]), PBO[0], o[0]); fb[0] = AT_VF(1, 0); { const int tk_ = (t) + 2 < NT ? (t) + 2 : NT - 1; AT_LDK(tk_); } AT_EXP(0); AT_FMA(1, SP0, SP1); AT_SB(); \
        o[0] = AT_MF(AT_B8(fa[1]), PBO[1], o[0]); fb[1] = AT_VF(1, 1); AT_LDV(t); AT_EXP(1); AT_ACC(0); AT_FMA(2, SP0, SP1); AT_SB(); \
        o[0] = AT_MF(AT_B8(fa[2]), PBO[2], o[0]); fb[2] = AT_VF(1, 2); AT_EXP(2); AT_ACC(1); AT_FMA(3, SP0, SP1); AT_SB(); \
        o[0] = AT_MF(AT_B8(fa[3]), PBO[3], o[0]); fb[3] = AT_VF(1, 3); AT_EXP(3); AT_ACC(2); AT_FMA(4, SP0, SP1); AT_SB(); \
        o[1] = AT_MF(AT_B8(fb[0]), PBO[0], o[1]); fa[0] = AT_VF(2, 0); AT_EXP(4); AT_ACC(3); AT_FMA(5, SP0, SP1); AT_SB(); \
        o[1] = AT_MF(AT_B8(fb[1]), PBO[1], o[1]); fa[1] = AT_VF(2, 1); AT_EXP(5); AT_ACC(4); AT_FMA(6, SP0, SP1); AT_SB(); \
        o[1] = AT_MF(AT_B8(fb[2]), PBO[2], o[1]); fa[2] = AT_VF(2, 2); AT_EXP(6); AT_ACC(5); AT_FMA(7, SP0, SP1); AT_SB(); \
        o[1] = AT_MF(AT_B8(fb[3]), PBO[3], o[1]); fa[3] = AT_VF(2, 3); AT_EXP(7); AT_ACC(6); AT_FMA(8, SP0, SP1); AT_SB(); \
        o[2] = AT_MF(AT_B8(fa[0]), PBO[0], o[2]); fb[0] = AT_VF(3, 0); AT_EXP(8); AT_ACC(7); AT_FMA(9, SP0, SP1); AT_SB(); \
        o[2] = AT_MF(AT_B8(fa[1]), PBO[1], o[2]); fb[1] = AT_VF(3, 1); AT_EXP(9); AT_ACC(8); AT_FMA(10, SP0, SP1); AT_SB(); \
        o[2] = AT_MF(AT_B8(fa[2]), PBO[2], o[2]); fb[2] = AT_VF(3, 2); AT_EXP(10); AT_ACC(9); AT_FMA(11, SP0, SP1); AT_SB(); \
        o[2] = AT_MF(AT_B8(fa[3]), PBO[3], o[2]); fb[3] = AT_VF(3, 3); AT_EXP(11); AT_ACC(10); AT_FMA(12, SP0, SP1); AT_SB(); \
        o[3] = AT_MF(AT_B8(fb[0]), PBO[0], o[3]); fa[0] = AT_KF(0, 0); AT_EXP(12); AT_ACC(11); AT_FMA(13, SP0, SP1); AT_SB(); \
        o[3] = AT_MF(AT_B8(fb[1]), PBO[1], o[3]); fa[1] = AT_KF(0, 1); AT_EXP(13); AT_ACC(12); AT_FMA(14, SP0, SP1); AT_SB(); \
        o[3] = AT_MF(AT_B8(fb[2]), PBO[2], o[3]); fa[2] = AT_KF(1, 0); AT_EXP(14); AT_ACC(13); AT_FMA(15, SP0, SP1); AT_SB(); \
        o[3] = AT_MF(AT_B8(fb[3]), PBO[3], o[3]); fa[3] = AT_KF(1, 1); bf16x8 qa_ = qf_(0); AT_EXP(15); AT_ACC(14); AT_SB(); \
        SQ0 = AT_MF(AT_B8(fa[0]), qa_, (f32x16){}); fb[0] = AT_KF(2, 0); AT_ACC(15); AT_SB(); \
        SQ1 = AT_MF(AT_B8(fa[1]), qa_, (f32x16){}); fb[1] = AT_KF(2, 1); bf16x8 qb_ = qf_(1); AT_SB(); \
        SQ0 = AT_MF(AT_B8(fa[2]), qb_, SQ0); fb[2] = AT_KF(3, 0); AT_SB(); \
        SQ1 = AT_MF(AT_B8(fa[3]), qb_, SQ1); fb[3] = AT_KF(3, 1); qa_ = qf_(2); AT_SB(); \
        SQ0 = AT_MF(AT_B8(fb[0]), qa_, SQ0); AT_WRK(t); AT_WRV(t); AT_SB();     \
        SQ1 = AT_MF(AT_B8(fb[1]), qa_, SQ1); qb_ = qf_(3); AT_SB(); \
        SQ0 = AT_MF(AT_B8(fb[2]), qb_, SQ0); AT_SB(); \
        SQ1 = AT_MF(AT_B8(fb[3]), qb_, SQ1); AT_SB(); \
        PBN[0] = AT_B8(wn_[0]); PBN[1] = AT_B8(wn_[1]); PBN[2] = AT_B8(wn_[2]); PBN[3] = AT_B8(wn_[3]); \
        l_reg = l_reg * alpha_ + (ps0_ + ps1_); m_reg = mn_; \
        if (need_) { _Pragma("unroll") for (int dt = 0; dt < 4; ++dt) o[dt] = o[dt] * alpha_; } \
        AT_BAR(); \
    } while (0)
    for (int t = 0; t < NT; t += 2) {
        AT_ITER(t, sa0, sa1, sb0, sb1, pba, pbb);
        AT_ITER(t + 1, sb0, sb1, sa0, sa1, pbb, pba);
    }
    {
        const unsigned vb_ = AT_VB + vro;
#pragma unroll
        for (int dt = 0; dt < 4; ++dt)
#pragma unroll
            for (int s_ = 0; s_ < 4; ++s_) { const v4u aw = *(const LAS v4u*)(lds + vb_ + dt * 32 * AT_VP + s_ * 32);
                o[dt] = AT_MF(AT_B8(aw), pba[s_], o[dt]); }
    }
    AT_BAR();
#undef AT_BL
#undef AT_LDK
#undef AT_LDV
#undef AT_WRK
#undef AT_WRV
#undef AT_MF
#undef AT_B8
#undef AT_SB
#undef AT_SPV
#undef AT_FMA
#undef AT_EXP
#undef AT_ACC
#undef AT_VF
#undef AT_KF
#undef AT_ITER
#undef qf_
    const float linv = 1.f / (l_reg + __shfl_xor(l_reg, 32));
    LAS float* ex = (LAS float*)(lds + AT_EX) + (size_t)(g * 32 + n) * AT_EXP;
    if (j == 1) {
        const float sc = linv * lam;
#pragma unroll
        for (int t = 0; t < 4; ++t)
#pragma unroll
            for (int r4 = 0; r4 < 4; ++r4) { const int dv = 32 * t + 8 * r4 + 4 * hi;
                *(LAS f32x4*)(ex + dv) = (f32x4){o[t][4 * r4] * sc, o[t][4 * r4 + 1] * sc, o[t][4 * r4 + 2] * sc, o[t][4 * r4 + 3] * sc}; }
    }
    __syncthreads();
    if (j == 0) {
        float ss = 0.f;
#pragma unroll
        for (int t = 0; t < 4; ++t)
#pragma unroll
            for (int r4 = 0; r4 < 4; ++r4) { const int dv = 32 * t + 8 * r4 + 4 * hi; const f32x4 e = *(const LAS f32x4*)(ex + dv);
#pragma unroll
                for (int k = 0; k < 4; ++k) { const float v = o[t][4 * r4 + k] * linv - e[k]; o[t][4 * r4 + k] = v; ss += v * v; } }
        ss += __shfl_xor(ss, 32);
        const float rs = 0.8f / sqrtf(ss * (1.f / 128.f) + 1e-5f);
        bf16* orow = MIX + (size_t)(tokbase + q0 + n) * D + 512 + h * 128;
#pragma unroll
        for (int t = 0; t < 4; ++t)
#pragma unroll
            for (int p2 = 0; p2 < 2; ++p2) {
                u32x2 eo[2];
#pragma unroll
                for (int q = 0; q < 2; ++q) { const int r4 = 2 * p2 + q, dv = 32 * t + 8 * r4 + 4 * hi; const f32x4 w = *(const f32x4*)(subln + dv);
                    eo[q].x = pk2(o[t][4 * r4] * rs * w.x, o[t][4 * r4 + 1] * rs * w.y); eo[q].y = pk2(o[t][4 * r4 + 2] * rs * w.z, o[t][4 * r4 + 3] * rs * w.w); }
                const auto sx = __builtin_amdgcn_permlane32_swap(eo[0].x, eo[1].x, false, false), sy = __builtin_amdgcn_permlane32_swap(eo[0].y, eo[1].y, false, false);
                const v4u ov = {sx[0], sy[0], sx[1], sy[1]};
                *(v4u*)(orow + 32 * t + 8 * (2 * p2 + hi)) = ov; }
    }
    __syncthreads();
}
__global__ void __launch_bounds__(512, 2) hymba_fwd(Args a) {
    extern __shared__ __attribute__((aligned(16))) unsigned char lds_raw[];
    cg::grid_group grid = cg::this_grid();
    const ldsp lds = (ldsp)lds_raw;
    const int tid = threadIdx.x, lane = tid & 63, wid = __builtin_amdgcn_readfirstlane(tid >> 6);
    const int G = gridDim.x, bx = blockIdx.x, gw = bx * 8 + wid, NGW = G * 8;
    unsigned char* ws = a.ws;
    bf16* WIN = (bf16*)(ws + WS_WIN); bf16* WOUT = (bf16*)(ws + WS_WOUT); bf16* W1 = (bf16*)(ws + WS_W1); bf16* W2 = (bf16*)(ws + WS_W2);
    float* MOD = (float*)(ws + WS_MOD); float* ROT = (float*)(ws + WS_ROT); bf16* KRP = (bf16*)(ws + WS_KRP); bf16* KRS = (bf16*)(ws + WS_KRS);
    bf16* XN = (bf16*)(ws + WS_XN); bf16* UT = (bf16*)(ws + WS_UT); bf16* QK = (bf16*)(ws + WS_QK); bf16* VT = (bf16*)(ws + WS_VT); bf16* YT = (bf16*)(ws + WS_YT);
    bf16* HB = (bf16*)(ws + WS_H); bf16* MIX = XN;
    const int lo = a.ph_lo, hi_ = a.ph_hi;
#ifndef PHMASK
#define PHMASK 0xffffffffu
#endif
#define IN(k) (((PHMASK >> ((k) < PH_MLP0 ? (k) : ((k) == PH_FINAL ? 9 : 7 + (((k) - PH_MLP0) & 1)))) & 1u) && lo <= (k) && (k) < hi_)
#define SEAM(k) do { if (IN(k) && IN((k) + 1)) grid.sync(); } while (0)

    if (IN(PH_P0)) {
#ifndef P0_NO_ADALN
        for (int it = bx; it < 6144 / 64; it += G) adaln_item(lds, a, MOD, it, tid, wid, lane);
#endif
        LAS float* scr = (LAS float*)(lds + wid * 16384);
        constexpr int I_IN = (D / 64) * (DIN / 32), I_O = (D / 64) * (D / 32), I_1 = (D / 64) * (FF / 32), I_2 = (FF / 64) * (D / 32), NTR = I_IN + I_O + I_1 + I_2;
        constexpr int I_FP = L_P / 32, I_FS = L_S / 32;
#ifndef P0_NO_FILT
        for (int it = NGW - 1 - gw; it < 3 * (I_FP + I_FS); it += NGW) { const int q = it / 3, part = it - 3 * q, np0 = part == 0 ? 0 : (part == 1 ? 6 : 11), npn = part == 0 ? 6 : 5;
            if (q < I_FP) filter_item32(a, L_P, KRP, 32 * q, np0, npn, lane); else filter_item32(a, L_S, KRS, 32 * (q - I_FP), np0, npn, lane); }
#endif
        for (int it = gw; it < NTR; it += NGW) {
            int r = it;
            if (r < I_IN) { p0_transpose_item(a.in[7], D, DIN, WIN, 0, scr, r, lane); continue; } r -= I_IN;
            if (r < I_O) { p0_transpose_item(a.in[25], D, D, WOUT, 0, scr, r, lane); continue; } r -= I_O;
            if (r < I_1) { p0_transpose_item(a.in[27], D, FF, W1, 0, scr, r, lane); continue; } r -= I_1;
            p0_transpose_item(a.in[28], FF, D, W2, 0, scr, r, lane);
        }
#ifndef P0_NO_ROT
        for (int idx = bx * 512 + tid; idx < L_P * 8; idx += G * 512) { const int pos = idx >> 3, i = idx & 7;
            const float invf = powf(500000.0f, -(float)i / 8.0f); const float ang = (float)pos * invf;
            ROT[pos * 16 + i] = (float)cos((double)ang); ROT[pos * 16 + 8 + i] = (float)sin((double)ang); }
#endif
    }
    SEAM(PH_P0);
    if (IN(PH_XN1)) {
        for (int row = gw; row < TT; row += 2 * NGW) { const int rb_ = row + NGW; const int mb = batch_of_row(row); const float* xr = row < T_P ? a.in[0] + (size_t)row * D : a.in[1] + (size_t)(row - T_P) * D;
            if (rb_ < TT) { const int mb2 = batch_of_row(rb_); const float* xr2 = rb_ < T_P ? a.in[0] + (size_t)rb_ * D : a.in[1] + (size_t)(rb_ - T_P) * D;
                norm_row2<0>(xr, xr2, a.in[6], MOD + mb * 6144 + 1024, MOD + mb * 6144, MOD + mb2 * 6144 + 1024, MOD + mb2 * 6144, XN + (size_t)row * D, XN + (size_t)rb_ * D, nullptr, nullptr, 1e-6f, lane); }
            else norm_row<0>(xr, a.in[6], MOD + mb * 6144 + 1024, MOD + mb * 6144, XN + (size_t)row * D, nullptr, 1e-6f, lane); }
    }
    SEAM(PH_XN1);
    if (IN(PH_INPROJ)) {
        { pg8::Gemm g{WIN, XN, 1536, TT, D}; pg8::StaticOrder S; S.init(1536, TT, G, bx); pg8::EpiBf16<0, false> E{UT, TT, nullptr};
          pg8::gemm_phase<pg8::EpiBf16<0, false>, pg8::StaticOrder, PG8_ALIGN, PG8_SP2>(lds, g, S, E); }
        __syncthreads();
        { pg8::Gemm g{XN, WIN + (size_t)1536 * D, TT, 1024, D}; pg8::StaticOrder S; S.init(TT, 1024, G, bx); pg8::EpiBf16<0, true> E{QK, 1024, ROT};
          pg8::gemm_phase<pg8::EpiBf16<0, true>, pg8::StaticOrder, PG8_ALIGN, PG8_SP2>(lds, g, S, E); }
        __syncthreads();
        { pg8::Gemm g{WIN + (size_t)2560 * D, XN, 512, TT, D}; pg8::StaticOrder S; S.init(512, TT, G, bx); pg8::EpiBf16<0, false> E{VT, TT, nullptr};
          pg8::gemm_phase<pg8::EpiBf16<0, false>, pg8::StaticOrder, PG8_ALIGN, PG8_SP2>(lds, g, S, E); }
    }
    SEAM(PH_INPROJ);
    if (IN(PH_MIX)) {
        for (int u = bx; u < HW + 2 * HW; u += G) hyena_unit(lds, a, UT, KRP, KRS, YT, u, tid, wid, lane);
        const float lam = expf(wave_sum(a.in[20][lane] * a.in[21][lane])) - expf(wave_sum(a.in[22][lane] * a.in[23][lane])) + 0.2f;
        for (int u = bx; u < 1024 + 2048; u += G) {
            int mb, h, qb, tokbase, L;
            if (G == 256) {
                const int x = bx & 7, c = bx >> 3, r = u >> 8;
                if (r < 4) { mb = x >> 2; h = x & 3; qb = c + 32 * r; tokbase = mb * L_P; L = L_P; }
                else { const int w = c + 32 * (r - 4), p = (w >> 4) * 8 + x; mb = p >> 2; h = p & 3; qb = w & 15; tokbase = T_P + mb * L_S; L = L_S; }
            } else if (u < 1024) { mb = u >> 9; h = (u >> 7) & 3; qb = u & 127; tokbase = mb * L_P; L = L_P; }
            else { const int v = u - 1024; mb = v >> 6; h = (v >> 4) & 3; qb = v & 15; tokbase = T_P + mb * L_S; L = L_S; }
            attn_unit(lds, QK, VT, MIX, a.in[24], lam, tokbase, L, h, qb, tid, wid, lane);
        }
    }
    SEAM(PH_MIX);
    if (IN(PH_HNORM)) hnorm_phase(lds, a, YT, MIX, bx, G, tid, wid, lane);
    SEAM(PH_HNORM);
    if (IN(PH_OUTPROJ)) {
        pg8::Gemm g{MIX, WOUT, TT, D, D}; pg8::StaticOrder S; S.init(TT, D, G, bx); pg8::EpiGateRes E{a.in[0], a.in[1], a.out, MOD + 2048, 0};
        pg8::gemm_phase<pg8::EpiGateRes, pg8::StaticOrder, PG8_ALIGN, PG8_SP2>(lds, g, S, E);
    }
    SEAM(PH_OUTPROJ);
    if (IN(PH_XN2)) {
        for (int row = gw; row < TT; row += 2 * NGW) { const int rb_ = row + NGW; const int mb = batch_of_row(row);
            if (rb_ < TT) { const int mb2 = batch_of_row(rb_);
                norm_row2<0>(a.out + (size_t)row * D, a.out + (size_t)rb_ * D, a.in[26], MOD + mb * 6144 + 4096, MOD + mb * 6144 + 3072, MOD + mb2 * 6144 + 4096, MOD + mb2 * 6144 + 3072, XN + (size_t)row * D, XN + (size_t)rb_ * D, nullptr, nullptr, 1e-6f, lane); }
            else norm_row<0>(a.out + (size_t)row * D, a.in[26], MOD + mb * 6144 + 4096, MOD + mb * 6144 + 3072, XN + (size_t)row * D, nullptr, 1e-6f, lane); }
    }
    SEAM(PH_XN2);
    for (int ch = 0; ch < N_CHUNK; ++ch) {
        if (IN(PH_MLP0 + 2 * ch)) {
            pg8::Gemm g{XN + (size_t)ch * MLP_CHUNK * D, W1, MLP_CHUNK, FF, D}; pg8::StaticOrder S; S.init(MLP_CHUNK, FF, G, bx); pg8::EpiBf16<2, false> E{HB, FF, nullptr};
            pg8::gemm_phase<pg8::EpiBf16<2, false>, pg8::StaticOrder, PG8_ALIGN, PG8_SP2>(lds, g, S, E);
        }
        SEAM(PH_MLP0 + 2 * ch);
        if (IN(PH_MLP0 + 2 * ch + 1)) {
            pg8::Gemm g{HB, W2, MLP_CHUNK, D, FF}; pg8::StaticOrder S; S.init(MLP_CHUNK, D, G, bx); pg8::EpiGateRes E{nullptr, nullptr, a.out, MOD + 5120, ch * MLP_CHUNK};
            pg8::gemm_phase<pg8::EpiGateRes, pg8::StaticOrder, PG8_ALIGN, PG8_SP2>(lds, g, S, E);
        }
        SEAM(PH_MLP0 + 2 * ch + 1);
    }
    if (IN(PH_FINAL)) {
        for (int row = gw; row < TT; row += 2 * NGW) { const int rb_ = row + NGW;
            if (rb_ < TT) norm_row2<1>(a.out + (size_t)row * D, a.out + (size_t)rb_ * D, a.in[29], nullptr, nullptr, nullptr, nullptr, nullptr, nullptr, a.out + (size_t)row * D, a.out + (size_t)rb_ * D, 1e-6f, lane);
            else norm_row<1>(a.out + (size_t)row * D, a.in[29], nullptr, nullptr, nullptr, a.out + (size_t)row * D, 1e-6f, lane); }
    }
#undef IN
#undef SEAM
}

#ifndef MK_PER_PHASE
#define MK_PER_PHASE 0
#endif
extern "C" void kernel_launch(void* const* d_in, const int* in_sizes, int n_in, void* d_out, int out_size, void* d_ws, size_t ws_size, hipStream_t stream) {
    static int grid = 0;
    if (grid == 0) {
        if (n_in != 30 || out_size != TT * D || ws_size < WS_END) { fprintf(stderr, "kernel_launch: unexpected shapes (n_in %d out %d ws %zu)\n", n_in, out_size, ws_size); grid = -1; return; }
        int dev = 0, cus = 0, per_cu = 0;
        hipGetDevice(&dev); hipDeviceGetAttribute(&cus, hipDeviceAttributeMultiprocessorCount, dev);
        if (hipFuncSetAttribute((const void*)hymba_fwd, hipFuncAttributeMaxDynamicSharedMemorySize, LDS_BYTES) != hipSuccess) { fprintf(stderr, "kernel_launch: hipFuncSetAttribute failed\n"); grid = -1; return; }
        if (hipOccupancyMaxActiveBlocksPerMultiprocessor(&per_cu, (const void*)hymba_fwd, 512, LDS_BYTES) != hipSuccess || per_cu < 1) { fprintf(stderr, "kernel_launch: occupancy query says %d\n", per_cu); per_cu = 1; }
        (void)hipGetLastError();
        grid = cus * per_cu;
    }
    if (grid < 0) return;
    Args a{};
    for (int i = 0; i < 30; ++i) a.in[i] = (const float*)d_in[i];
    a.out = (float*)d_out; a.ws = (unsigned char*)d_ws;
#if MK_PER_PHASE
    for (int p = 0; p < N_PHASES; ++p) { a.ph_lo = p; a.ph_hi = p + 1; void* args[] = {&a};
        hipError_t e = hipLaunchCooperativeKernel((const void*)hymba_fwd, dim3(grid), dim3(512), args, LDS_BYTES, stream);
        if (e != hipSuccess) { fprintf(stderr, "launch %d failed: %s\n", p, hipGetErrorString(e)); break; } }
#else
    a.ph_lo = 0; a.ph_hi = N_PHASES; void* args[] = {&a};
    hipError_t e = hipLaunchCooperativeKernel((const void*)hymba_fwd, dim3(grid), dim3(512), args, LDS_BYTES, stream);
    if (e != hipSuccess) fprintf(stderr, "cooperative launch failed: %s (grid %d)\n", hipGetErrorString(e), grid);
#endif
}
```

```cpp
#include <hip/hip_runtime.h>
#include <hip/hip_cooperative_groups.h>
#include <cstdio>
#include <cstdint>
namespace cg = cooperative_groups;
namespace pg8 {
#define PG8_LAS __attribute__((address_space(3)))
typedef unsigned short bf16_t;
typedef short bf16x8 __attribute__((ext_vector_type(8)));
typedef float f32x4 __attribute__((ext_vector_type(4)));
typedef unsigned u32x4 __attribute__((ext_vector_type(4)));
constexpr int BM = 256, BK = 64, HALF = 128, HTB = HALF * BK * 2  , STAGE_BYTES = 8 * HTB, NXCD = 8, WGM = 8;

__host__ __device__ __forceinline__ int lds_byte(int r, int c) { const int st = (r >> 4) * 2 + (c >> 5), rr = r & 15, cc = c & 31, ob = rr * 64 + cc * 2; return st * 1024 + (ob ^ (((ob >> 9) & 1) << 5)); }
__host__ __device__ __forceinline__ void stage_rc(int b, int& R, int& C) { const int st = b / 1024, sb = b % 1024, swz = sb ^ (((sb >> 9) & 1) << 5); R = (st >> 1) * 16 + swz / 64; C = (st & 1) * 32 + (swz % 64) / 2; }
__host__ __device__ __forceinline__ int perm32(int rho) { const int n = rho >> 4, i = rho & 15; return 8 * (i >> 2) + 4 * n + (i & 3); }

struct Unit { int pm, pn; };
struct Gemm { const bf16_t* A; const bf16_t* Bt; int M, N, K; };

struct StaticOrder {
    int nM, nN, nwg, G, c;
    __host__ __device__ void init(int M, int N, int G_, int c_) { nM = M / BM; nN = N / BM; nwg = nM * nN; G = G_; c = c_; }
    __host__ __device__ bool next(int i, Unit& u) const {
        const long L = (long)i * G + c; if (L >= nwg) return false;
        int wgid = (int)L; { const int q = nwg / NXCD, r = nwg % NXCD, xcd = wgid % NXCD, off = wgid / NXCD; wgid = (xcd < r ? xcd * (q + 1) : r * (q + 1) + (xcd - r) * q) + off; }
        const int nig = WGM * nN, gid = wgid / nig, fm = gid * WGM, gsz = (nM - fm) < WGM ? (nM - fm) : WGM;
        u.pm = fm + ((wgid % nig) % gsz); u.pn = (wgid % nig) / gsz; return true;
    }
    __device__ __forceinline__ void a_ready(const Unit&) const {}
    __device__ __forceinline__ void done(const Unit&) const {}
};

typedef __bf16 pg8_bf16x2 __attribute__((ext_vector_type(2))); typedef float pg8_f32x2 __attribute__((ext_vector_type(2)));
__device__ __forceinline__ unsigned cvt_pk_bf16(float lo, float hi) { const pg8_f32x2 v = {lo, hi}; return __builtin_bit_cast(unsigned, __builtin_convertvector(v, pg8_bf16x2)); }
template <int ACT, bool ROT> struct EpiBf16 {
    static constexpr bool PERM = true, AFTER_DRAIN = false;
    bf16_t* O; int ldc; const float* rot;
    __device__ __forceinline__ void operator()(const f32x4 (&acc)[2][2][4][2], const Unit& u, int wr, int wc, int fr, int fq) const {
        const int row0 = u.pm * BM + wr * 64 + fr;
        const int col0 = u.pn * BM + wc * 32 + 8 * fq;
#pragma unroll
        for (int ai = 0; ai < 2; ++ai)
#pragma unroll
            for (int m = 0; m < 4; ++m) {
                const int row = row0 + ai * HALF + m * 16;
                bf16_t* rowp = O + (size_t)row * ldc + col0;
                f32x4 c0 = {1.f, 1.f, 1.f, 1.f}, c1 = c0, s0 = {0.f, 0.f, 0.f, 0.f}, s1 = s0;
                if (ROT) { if ((wc & 1) == 0 && fq < 2) { const int pos = row < 32768 ? (row & 16383) : (row & 2047); const f32x4* tp = (const f32x4*)(rot + (size_t)pos * 16);
                        c0 = tp[0]; c1 = tp[1]; s0 = tp[2]; s1 = tp[3]; if (fq == 0) { s0 = -s0; s1 = -s1; } } }
#pragma unroll
                for (int bj = 0; bj < 2; ++bj) { f32x4 v0 = acc[ai][bj][m][0], v1 = acc[ai][bj][m][1];
                    if (ACT == 2) {
#pragma unroll
                        for (int e = 0; e < 4; ++e) { const float a0 = fmaxf(v0[e], 0.f), a1 = fmaxf(v1[e], 0.f); v0[e] = a0 * a0; v1[e] = a1 * a1; } }
                    if (ROT) { if ((wc & 1) == 0) { f32x4 p0, p1;
#pragma unroll
                            for (int e = 0; e < 4; ++e) { p0[e] = __shfl_xor(v0[e], 16); p1[e] = __shfl_xor(v1[e], 16); }
                            v0 = v0 * c0 + p0 * s0; v1 = v1 * c1 + p1 * s1; } }
                    u32x4 w; w.x = cvt_pk_bf16(v0[0], v0[1]); w.y = cvt_pk_bf16(v0[2], v0[3]); w.z = cvt_pk_bf16(v1[0], v1[1]); w.w = cvt_pk_bf16(v1[2], v1[3]);
                    *(u32x4*)(rowp + bj * HALF) = w; } }
    }
};
struct EpiGateRes {
    static constexpr bool PERM = false, AFTER_DRAIN = false;
    const float* xp; const float* xs; float* out; const float* gate; int row_off;
    __device__ __forceinline__ void operator()(const f32x4 (&acc)[2][2][4][2], const Unit& u, int wr, int wc, int fr, int fq) const {
        const int grow0 = row_off + u.pm * BM;
        const int mb = grow0 < 32768 ? (grow0 >> 14) : 2 + ((grow0 - 32768) >> 11);
        const int col0 = u.pn * BM + wc * 32 + 4 * fq;
        const float* gp = gate + (size_t)mb * 6144 + col0;
        f32x4 gv[2][2];
#pragma unroll
        for (int bj = 0; bj < 2; ++bj)
#pragma unroll
            for (int n = 0; n < 2; ++n) gv[bj][n] = *(const f32x4*)(gp + bj * HALF + n * 16);
#pragma unroll
        for (int ai = 0; ai < 2; ++ai)
#pragma unroll
            for (int m = 0; m < 4; ++m) { const int row = grow0 + ai * HALF + wr * 64 + m * 16 + fr;
                const float* bp = (xp ? (row < 32768 ? xp + (size_t)row * 1024 : xs + (size_t)(row - 32768) * 1024) : out + (size_t)row * 1024) + col0;
                float* op = out + (size_t)row * 1024 + col0;
#pragma unroll
                for (int bj = 0; bj < 2; ++bj)
#pragma unroll
                    for (int n = 0; n < 2; ++n) { const f32x4 b = *(const f32x4*)(bp + bj * HALF + n * 16); *(f32x4*)(op + bj * HALF + n * 16) = b + gv[bj][n] * acc[ai][bj][m][n]; }
                if (m & 1) asm volatile("" ::: "memory"); }
    }
};
template <class Epi, class Sched, bool ALIGN_EPI = false, bool SP2 = false>
__device__ __forceinline__ void gemm_phase(PG8_LAS unsigned char* lds, const Gemm g, const Sched& S, const Epi& E) {
    int tid_ = threadIdx.x; asm volatile("" : "+v"(tid_));
    const int tid = tid_, wid = __builtin_amdgcn_readfirstlane(tid >> 6), lane = tid & 63, wr = wid >> 2, wc = wid & 3, fr = lane & 15, fq = lane >> 4;
    const int K = g.K, nt = K / BK;
    unsigned voffA[2], voffB[2];
#pragma unroll
    for (int i = 0; i < 2; ++i) { int R, C; stage_rc(tid * 16 + i * 8192, R, C); const int Rb = Epi::PERM ? ((R & ~31) + perm32(R & 31)) : R;
        voffA[i] = (unsigned)(R * K + C) * 2u; voffB[i] = (unsigned)(Rb * K + C) * 2u; }
    const size_t kstep = (size_t)(BK * 2);
    const size_t hstep = (size_t)HALF * K * 2;
    const size_t tstep = 2 * hstep;
    const unsigned ldsw = (unsigned)wid * 1024u;
    const int aoff = lds_byte(wr * 64 + fr, fq * 8), boff = lds_byte(wc * 32 + fr, fq * 8);
#define PG8_SA(b, h) (((b) * 2 + (h)) * HTB)
#define PG8_SB(b, h) ((4 + (b) * 2 + (h)) * HTB)
#define PG8_STAGE(bufoff, gbase, voff) do { _Pragma("unroll") for (int _i = 0; _i < 2; ++_i) \
        __builtin_amdgcn_global_load_lds((const unsigned*)((const char*)(gbase) + (voff)[_i]), (PG8_LAS unsigned*)(lds + (bufoff) + ldsw + _i * 8192), 16, 0, 0); } while (0)
#define PG8_LDA(dst, b, h) do { _Pragma("unroll") for (int m = 0; m < 4; ++m) _Pragma("unroll") for (int k = 0; k < 2; ++k) dst[m][k] = *(const PG8_LAS bf16x8*)(lds + PG8_SA(b, h) + aoff + m * 2048 + k * 1024); } while (0)
#define PG8_LDB(dst, b, h) do { _Pragma("unroll") for (int n = 0; n < 2; ++n) _Pragma("unroll") for (int k = 0; k < 2; ++k) dst[n][k] = *(const PG8_LAS bf16x8*)(lds + PG8_SB(b, h) + boff + n * 2048 + k * 1024); } while (0)
#define PG8_MMA(ai, bj, At, Bt) do { __builtin_amdgcn_s_setprio(1); _Pragma("unroll") for (int m = 0; m < 4; ++m) _Pragma("unroll") for (int n = 0; n < 2; ++n) _Pragma("unroll") for (int k = 0; k < 2; ++k) \
        acc[ai][bj][m][n] = __builtin_amdgcn_mfma_f32_16x16x32_bf16(Bt[n][k], At[m][k], acc[ai][bj][m][n], 0, 0, 0); __builtin_amdgcn_s_setprio(0); } while (0)
#define PG8_WAIT_V(n) asm volatile("s_waitcnt vmcnt(" #n ")" ::: "memory")
#define PG8_WAIT_L(n) asm volatile("s_waitcnt lgkmcnt(" #n ")" ::: "memory")
#define PG8_BAR __builtin_amdgcn_s_barrier()
#define PG8_SCHED __builtin_amdgcn_sched_barrier(0)
    Unit cur, nxt; int ui = 0;
    if (!S.next(0, cur)) return;
    f32x4 acc[2][2][4][2];
#pragma unroll
    for (int a = 0; a < 2; ++a)
#pragma unroll
        for (int b = 0; b < 2; ++b)
#pragma unroll
            for (int m = 0; m < 4; ++m)
#pragma unroll
                for (int n = 0; n < 2; ++n) acc[a][b][m][n] = (f32x4){0.f, 0.f, 0.f, 0.f};
    bf16x8 At[4][2], B0[2][2], B1[2][2];
    const char* cA = (const char*)g.A + (size_t)cur.pm * tstep; const char* cB = (const char*)g.Bt + (size_t)cur.pn * tstep;
    S.a_ready(cur);
    if constexpr (SP2) {
        PG8_STAGE(PG8_SB(0, 0), cB, voffB); PG8_STAGE(PG8_SB(0, 1), cB + hstep, voffB); PG8_STAGE(PG8_SA(0, 0), cA, voffA); PG8_STAGE(PG8_SA(0, 1), cA + hstep, voffA);
        if (wr == 1) PG8_BAR;
        PG8_WAIT_V(2); PG8_BAR;
        PG8_STAGE(PG8_SB(1, 0), cB + kstep, voffB); PG8_STAGE(PG8_SA(1, 0), cA + kstep, voffA); PG8_STAGE(PG8_SB(1, 1), cB + hstep + kstep, voffB);
        PG8_WAIT_V(6); PG8_BAR;
    } else {
        PG8_STAGE(PG8_SB(0, 0), cB, voffB); PG8_STAGE(PG8_SA(0, 0), cA, voffA); PG8_STAGE(PG8_SB(0, 1), cB + hstep, voffB); PG8_STAGE(PG8_SA(0, 1), cA + hstep, voffA);
        if (wr == 1) PG8_BAR;
        PG8_WAIT_V(4); PG8_BAR;
        PG8_STAGE(PG8_SB(1, 0), cB + kstep, voffB); PG8_STAGE(PG8_SA(1, 0), cA + kstep, voffA); PG8_STAGE(PG8_SB(1, 1), cB + hstep + kstep, voffB);
        PG8_WAIT_V(6); PG8_BAR;
    }
    for (;;) {
        const bool has_next = S.next(ui + 1, nxt);
        const char* nA = has_next ? (const char*)g.A + (size_t)nxt.pm * tstep : cA; const char* nB = has_next ? (const char*)g.Bt + (size_t)nxt.pn * tstep : cB;
        for (int t = 0; t < nt; t += 2) {
            const bool last = (t == nt - 2);
            const char* a1 = cA + (size_t)(t + 1) * kstep;
            const char* a2 = last ? nA : cA + (size_t)(t + 2) * kstep; const char* b2 = last ? nB : cB + (size_t)(t + 2) * kstep;
            const char* a3 = a2 + kstep; const char* b3 = b2 + kstep;
            if (last && has_next) S.a_ready(nxt);
            if constexpr (SP2) {
            PG8_LDB(B0, 0, 0); PG8_LDB(B1, 0, 1); PG8_SCHED; PG8_LDA(At, 0, 0); PG8_STAGE(PG8_SA(1, 1), a1 + hstep, voffA);
            PG8_WAIT_V(8); PG8_WAIT_L(0); PG8_BAR; PG8_MMA(0, 0, At, B0); PG8_MMA(0, 1, At, B1); PG8_BAR; PG8_SCHED;
            PG8_LDA(At, 0, 1); PG8_STAGE(PG8_SB(0, 0), b2, voffB); PG8_STAGE(PG8_SB(0, 1), b2 + hstep, voffB); PG8_STAGE(PG8_SA(0, 0), a2, voffA);
            PG8_WAIT_V(8); PG8_WAIT_L(0); PG8_BAR; PG8_MMA(1, 0, At, B0); PG8_MMA(1, 1, At, B1); PG8_BAR; PG8_SCHED;
            PG8_LDB(B0, 1, 0); PG8_LDB(B1, 1, 1); PG8_SCHED; PG8_LDA(At, 1, 0); PG8_STAGE(PG8_SA(0, 1), a2 + hstep, voffA);
            PG8_WAIT_V(8); PG8_WAIT_L(0); PG8_BAR; PG8_MMA(0, 0, At, B0); PG8_MMA(0, 1, At, B1); PG8_BAR; PG8_SCHED;
            PG8_LDA(At, 1, 1); PG8_STAGE(PG8_SB(1, 0), b3, voffB); PG8_STAGE(PG8_SB(1, 1), b3 + hstep, voffB); PG8_STAGE(PG8_SA(1, 0), a3, voffA);
            PG8_WAIT_V(8); PG8_WAIT_L(0); PG8_BAR; PG8_MMA(1, 0, At, B0); PG8_MMA(1, 1, At, B1); PG8_BAR; PG8_SCHED;
            } else {
            PG8_LDB(B0, 0, 0); PG8_SCHED; PG8_LDA(At, 0, 0); PG8_STAGE(PG8_SA(1, 1), a1 + hstep, voffA);
            PG8_WAIT_L(8); PG8_BAR; PG8_WAIT_L(0); PG8_MMA(0, 0, At, B0); PG8_BAR; PG8_SCHED;
            PG8_LDB(B1, 0, 1); PG8_STAGE(PG8_SB(0, 0), b2, voffB);
            PG8_BAR; PG8_WAIT_L(0); PG8_MMA(0, 1, At, B1); PG8_BAR;
            PG8_LDA(At, 0, 1); PG8_STAGE(PG8_SA(0, 0), a2, voffA);
            PG8_BAR; PG8_WAIT_L(0); PG8_MMA(1, 0, At, B0); PG8_BAR; PG8_SCHED;
            PG8_STAGE(PG8_SB(0, 1), b2 + hstep, voffB);
            PG8_WAIT_V(6); PG8_BAR; PG8_MMA(1, 1, At, B1); PG8_BAR;
            PG8_LDB(B0, 1, 0); PG8_SCHED; PG8_LDA(At, 1, 0); PG8_STAGE(PG8_SA(0, 1), a2 + hstep, voffA);
            PG8_WAIT_L(8); PG8_BAR; PG8_WAIT_L(0); PG8_MMA(0, 0, At, B0); PG8_BAR; PG8_SCHED;
            PG8_LDB(B1, 1, 1); PG8_STAGE(PG8_SB(1, 0), b3, voffB);
            PG8_BAR; PG8_WAIT_L(0); PG8_MMA(0, 1, At, B1); PG8_BAR;
            PG8_LDA(At, 1, 1); PG8_STAGE(PG8_SA(1, 0), a3, voffA);
            PG8_BAR; PG8_WAIT_L(0); PG8_MMA(1, 0, At, B0); PG8_BAR; PG8_SCHED;
            PG8_STAGE(PG8_SB(1, 1), b3 + hstep, voffB);
            PG8_WAIT_V(6); PG8_BAR; PG8_MMA(1, 1, At, B1); PG8_BAR;
            }
        }
        if constexpr (ALIGN_EPI) { if (wr == 0) PG8_BAR; }
        if constexpr (!Epi::AFTER_DRAIN) { E(acc, cur, wr, wc, fr, fq); S.done(cur); }
        if (!has_next) break;
#pragma unroll
        for (int a = 0; a < 2; ++a)
#pragma unroll
            for (int b = 0; b < 2; ++b)
#pragma unroll
                for (int m = 0; m < 4; ++m)
#pragma unroll
                    for (int n = 0; n < 2; ++n) acc[a][b][m][n] = (f32x4){0.f, 0.f, 0.f, 0.f};
        cur = nxt; cA = nA; cB = nB; ++ui;
        if constexpr (ALIGN_EPI) { if (wr == 1) PG8_BAR; }
    }
    PG8_WAIT_V(0);
    if constexpr (!ALIGN_EPI) { if (wr == 0) PG8_BAR; }
    PG8_BAR;
    if constexpr (Epi::AFTER_DRAIN) { E.fused(acc, cur, wr, wc, fr, fq, lds, wid, lane); S.done(cur); }
#undef PG8_SA
#undef PG8_SB
#undef PG8_STAGE
#undef PG8_LDA
#undef PG8_LDB
#undef PG8_MMA
#undef PG8_WAIT_V
#undef PG8_WAIT_L
#undef PG8_BAR
#undef PG8_SCHED
}
}
#ifndef PG8_SP2
#define PG8_SP2 true
#endif
#ifndef PG8_ALIGN
#define PG8_ALIGN true
#endif
constexpr int D = 1024, T_P = 32768, T_S = 65536, TT = T_P + T_S, L_P = 16384, L_S = 2048, NB_ROWS = 34, DIN = 3072, FF = 4096, HW = 512;
constexpr size_t MiB = 1u << 20;
constexpr size_t WS_WIN = 2 * MiB, WS_WOUT = 8 * MiB, WS_W1 = 10 * MiB, WS_W2 = 18 * MiB, WS_MOD = 26 * MiB, WS_ROT = 27 * MiB, WS_KRP = 28 * MiB, WS_KRS = 60 * MiB,
                 WS_XN = 64 * MiB, WS_UT = 256 * MiB, WS_QK = 544 * MiB, WS_VT = 736 * MiB, WS_YT = 832 * MiB, WS_END = 928 * MiB, WS_H = WS_UT;
constexpr int MLP_CHUNK = 49152, N_CHUNK = TT / MLP_CHUNK;
constexpr int LDS_BYTES = 147456;
constexpr int PH_P0 = 0, PH_XN1 = 1, PH_INPROJ = 2, PH_MIX = 3, PH_HNORM = 4, PH_OUTPROJ = 5, PH_XN2 = 6, PH_MLP0 = 7, PH_FINAL = PH_MLP0 + 2 * N_CHUNK, N_PHASES = PH_FINAL + 1;

#define GAS __attribute__((address_space(1)))
#define LAS __attribute__((address_space(3)))
typedef unsigned short bf16;
typedef unsigned v4u __attribute__((ext_vector_type(4)));
typedef unsigned u32x2 __attribute__((ext_vector_type(2)));
typedef float f32x4 __attribute__((ext_vector_type(4)));
typedef float f32x16 __attribute__((ext_vector_type(16)));
typedef short bf16x8 __attribute__((ext_vector_type(8)));
typedef short s16x4 __attribute__((ext_vector_type(4)));
typedef LAS unsigned char* ldsp;
#define LDS_WAIT() asm volatile("s_waitcnt lgkmcnt(0)" ::: "memory")
__device__ __forceinline__ unsigned f2bf(float f) { unsigned u = __builtin_bit_cast(unsigned, f); return (u + 0x7fffu + ((u >> 16) & 1u)) >> 16; }
__device__ __forceinline__ unsigned pk2(float lo, float hi) { return f2bf(lo) | (f2bf(hi) << 16); }
__device__ __forceinline__ float bflo(unsigned w) { return __builtin_bit_cast(float, w << 16); }
__device__ __forceinline__ float bfhi(unsigned w) { return __builtin_bit_cast(float, w & 0xffff0000u); }
__device__ __forceinline__ float bf2f(unsigned short b) { return __builtin_bit_cast(float, ((unsigned)b) << 16); }
__device__ __forceinline__ float wave_sum(float v) {
#pragma unroll
    for (int o = 1; o < 64; o <<= 1) v += __shfl_xor(v, o);
    return v;
}
__device__ __forceinline__ float rdlane(float v, int i) { return __builtin_bit_cast(float, __builtin_amdgcn_readlane(__builtin_bit_cast(int, v), i)); }
__device__ __forceinline__ int batch_of_row(int row) { return row < T_P ? (row >> 14) : 2 + ((row - T_P) >> 11); }

struct Args { const float* in[30]; float* out; unsigned char* ws; int ph_lo, ph_hi; };

__device__ __forceinline__ void p0_transpose_item(const float* W, int K, int N, bf16* WT, int row_off, LAS float* scr, int item, int lane) {
    const int nblk = N / 32, kb = item / nblk, nb = item % nblk, k0 = 64 * kb, n0 = 32 * nb;
    float tv[32];
#pragma unroll
    for (int i = 0; i < 32; ++i) tv[i] = W[(size_t)(k0 + 2 * i + (lane >> 5)) * N + n0 + (lane & 31)];
#pragma unroll
    for (int i = 0; i < 32; ++i) scr[(2 * i + (lane >> 5)) * 33 + (lane & 31)] = tv[i];
    LDS_WAIT(); asm volatile("" ::: "memory");
    const int c = lane & 7;
#pragma unroll
    for (int j = 0; j < 4; ++j) { const int n = (lane >> 3) + 8 * j; const LAS float* s = scr + (8 * c) * 33 + n;
        v4u o; o.x = pk2(s[0 * 33], s[1 * 33]); o.y = pk2(s[2 * 33], s[3 * 33]); o.z = pk2(s[4 * 33], s[5 * 33]); o.w = pk2(s[6 * 33], s[7 * 33]);
        *(GAS v4u*)(WT + (size_t)(row_off + n0 + n) * K + k0 + 8 * c) = o; }
    LDS_WAIT(); asm volatile("" ::: "memory");
}
__device__ __forceinline__ void adaln_item(ldsp lds, const Args& a, float* MOD, int item, int tid, int wid, int lane) {
    LAS float* sc = (LAS float*)lds;
    const float* cp = a.in[2]; const float* cs = a.in[3];
    for (int idx = tid; idx < NB_ROWS * D; idx += 512) { const int r = idx >> 10, k = idx & 1023; const float x = r < 2 ? cp[r * D + k] : cs[(r - 2) * D + k]; sc[idx] = x / (1.f + expf(-x)); }
    __syncthreads();
    const int n0 = item * 64; const float* W = a.in[4] + n0 + lane;
    float acc[NB_ROWS];
#pragma unroll
    for (int r = 0; r < NB_ROWS; ++r) acc[r] = 0.f;
    for (int k = wid * 128; k < wid * 128 + 128; k += 4) {
        const float w0 = W[(size_t)k * 6144], w1 = W[(size_t)(k + 1) * 6144], w2 = W[(size_t)(k + 2) * 6144], w3 = W[(size_t)(k + 3) * 6144];
#pragma unroll
        for (int r = 0; r < NB_ROWS; ++r) { const f32x4 s = *(const LAS f32x4*)(sc + r * D + k); acc[r] += (s.x * w0 + s.y * w1) + (s.z * w2 + s.w * w3); }
    }
    __syncthreads();
    LAS float* part = (LAS float*)lds;
#pragma unroll
    for (int r = 0; r < NB_ROWS; ++r) part[(wid * NB_ROWS + r) * 64 + lane] = acc[r];
    __syncthreads();
    for (int r = wid; r < NB_ROWS; r += 8) { float s = a.in[5][n0 + lane];
#pragma unroll
        for (int p = 0; p < 8; ++p) s += part[(p * NB_ROWS + r) * 64 + lane];
        MOD[(size_t)r * 6144 + n0 + lane] = s; }
    __syncthreads();
}

__device__ __forceinline__ int crow16(int r, int hi) { return (r & 3) + 8 * (r >> 2) + 4 * hi; }
__device__ __forceinline__ void filter_item32(const Args& a, int L, bf16* KR, int t0, int np0, int npn, int lane) {
    const float *w1 = a.in[10], *b1 = a.in[11], *w2 = a.in[12], *b2 = a.in[13], *w3 = a.in[14], *b3 = a.in[15], *w4 = a.in[16], *fq = a.in[17];
    const int n = lane & 31, hi = lane >> 5, t = t0 + n;
    const float tt = (float)t * (1.0f / (float)(L - 1)), w = 6.283185307179586f * (float)t / (float)L;
    f32x16 h0 = {}, h1 = {};
    {
        float cv[8], sv[8];
#pragma unroll
        for (int k = 0; k < 8; ++k) { const float f = 1e-4f + (float)(k + 8 * hi) * ((15.0f - 1e-4f) / 15.0f); float s, c; sincosf(f * w, &s, &c); cv[k] = c; sv[k] = -s; }
#pragma unroll
        for (int kk = 0; kk < 17; ++kk) {
            const int urow = kk < 8 ? 1 + kk : (kk < 16 ? 17 + (kk - 8) : 0);
            const float zb = kk < 8 ? cv[kk & 7] : (kk < 16 ? sv[kk & 7] : (hi == 0 ? tt : 0.f));
            const float* ub = w1 + urow * 64; const int lo1 = kk < 16 ? 8 * hi * 64 + n : n;
            const float a0 = ub[lo1], a1 = ub[lo1 + 32];
            h0 = __builtin_amdgcn_mfma_f32_32x32x2f32(a0, zb, h0, 0, 0, 0); h1 = __builtin_amdgcn_mfma_f32_32x32x2f32(a1, zb, h1, 0, 0, 0);
        }
#pragma unroll
        for (int r = 0; r < 16; ++r) { const int j = crow16(r, hi); h0[r] = sinf(fq[j] * (h0[r] + b1[j])); h1[r] = sinf(fq[32 + j] * (h1[r] + b1[32 + j])); }
    }
#pragma unroll
    for (int layer = 0; layer < 2; ++layer) {
        const float* W = layer ? w3 : w2; const float* bb = layer ? b3 : b2;
        f32x16 g0 = {}, g1 = {}; const int lo2 = 4 * hi * 64 + n;
#pragma unroll
        for (int kk = 0; kk < 32; ++kk) {
            const float* ub = W + (32 * (kk >> 4) + crow16(kk & 15, 0)) * 64;
            const float zb = kk < 16 ? h0[kk & 15] : h1[kk & 15];
            const float a0 = ub[lo2], a1 = ub[lo2 + 32];
            g0 = __builtin_amdgcn_mfma_f32_32x32x2f32(a0, zb, g0, 0, 0, 0); g1 = __builtin_amdgcn_mfma_f32_32x32x2f32(a1, zb, g1, 0, 0, 0);
        }
#pragma unroll
        for (int r = 0; r < 16; ++r) { const int j = crow16(r, hi); h0[r] = sinf(fq[j] * (g0[r] + bb[j])); h1[r] = sinf(fq[32 + j] * (g1[r] + bb[32 + j])); }
    }
    const float dmin = -3.0701134573253943f, dmax = -15.350567286626972f;
#pragma unroll 1
    for (int np = np0; np < np0 + npn; ++np) {
        f32x16 of = {}, ob = {};
        const float* wr = w4 + 32 * np; const int lo4 = 4 * hi * 1024 + n;
#pragma unroll
        for (int kk = 0; kk < 32; ++kk) {
            const float* ub = wr + (32 * (kk >> 4) + crow16(kk & 15, 0)) * 1024;
            const float zb = kk < 16 ? h0[kk & 15] : h1[kk & 15];
            const float af = ub[lo4], ab = ub[lo4 + 512];
            of = __builtin_amdgcn_mfma_f32_32x32x2f32(af, zb, of, 0, 0, 0); ob = __builtin_amdgcn_mfma_f32_32x32x2f32(ab, zb, ob, 0, 0, 0);
        }
#pragma unroll
        for (int r = 0; r < 16; ++r) { const int c = 32 * np + crow16(r, hi); const float ad = -(dmin + (float)c * ((dmax - dmin) / 511.0f));
            const float dec = expf(-tt * ad); bf16* kr = KR + (size_t)c * (2 * L);
            if (t == 0) { kr[L] = (bf16)f2bf(of[r] + ob[r]); kr[0] = 0; } else { kr[L - t] = (bf16)f2bf(of[r] * dec); kr[L + t] = (bf16)f2bf(ob[r] * dec); } }
    }
}

template <int MODE> __device__ __forceinline__ void norm_row(const float* xrow, const float* nw, const float* sc, const float* sh, bf16* orow, float* frow, float eps, int lane) {
    const f32x4* xr = (const f32x4*)xrow + lane;
    f32x4 v[4]; float s = 0.f;
#pragma unroll
    for (int j = 0; j < 4; ++j) { v[j] = xr[64 * j]; s += (v[j].x * v[j].x + v[j].y * v[j].y) + (v[j].z * v[j].z + v[j].w * v[j].w); }
    const float r = 1.f / sqrtf(wave_sum(s) * (1.f / D) + eps);
#pragma unroll
    for (int j = 0; j < 4; ++j) { const f32x4 w = ((const f32x4*)nw)[64 * j + lane]; f32x4 y = v[j] * r * w;
        if (MODE == 0) { const f32x4 c = ((const f32x4*)sc)[64 * j + lane], h = ((const f32x4*)sh)[64 * j + lane]; y = y * (c + 1.f) + h;
            u32x2 o; o.x = pk2(y.x, y.y); o.y = pk2(y.z, y.w); ((u32x2*)orow)[64 * j + lane] = o; }
        else ((f32x4*)frow)[64 * j + lane] = y; }
}
template <int MODE> __device__ __forceinline__ void norm_row2(const float* xa, const float* xb, const float* nw, const float* sca, const float* sha, const float* scb, const float* shb,
                                                              bf16* oa, bf16* ob, float* fa_, float* fb_, float eps, int lane) {
    const f32x4* pa = (const f32x4*)xa + lane; const f32x4* pb = (const f32x4*)xb + lane;
    f32x4 va[4], vb[4]; float s0 = 0.f, s1 = 0.f;
#pragma unroll
    for (int j = 0; j < 4; ++j) { va[j] = pa[64 * j]; vb[j] = pb[64 * j]; }
#pragma unroll
    for (int j = 0; j < 4; ++j) { s0 += (va[j].x * va[j].x + va[j].y * va[j].y) + (va[j].z * va[j].z + va[j].w * va[j].w); s1 += (vb[j].x * vb[j].x + vb[j].y * vb[j].y) + (vb[j].z * vb[j].z + vb[j].w * vb[j].w); }
#pragma unroll
    for (int o = 1; o < 64; o <<= 1) { s0 += __shfl_xor(s0, o); s1 += __shfl_xor(s1, o); }
    const float r0 = 1.f / sqrtf(s0 * (1.f / D) + eps), r1 = 1.f / sqrtf(s1 * (1.f / D) + eps);
#pragma unroll
    for (int j = 0; j < 4; ++j) { const f32x4 w = ((const f32x4*)nw)[64 * j + lane]; f32x4 ya = va[j] * r0 * w, yb = vb[j] * r1 * w;
        if (MODE == 0) { const f32x4 ca = ((const f32x4*)sca)[64 * j + lane], ha = ((const f32x4*)sha)[64 * j + lane], cb = ((const f32x4*)scb)[64 * j + lane], hb = ((const f32x4*)shb)[64 * j + lane];
            ya = ya * (ca + 1.f) + ha; yb = yb * (cb + 1.f) + hb;
            u32x2 o; o.x = pk2(ya.x, ya.y); o.y = pk2(ya.z, ya.w); ((u32x2*)oa)[64 * j + lane] = o; o.x = pk2(yb.x, yb.y); o.y = pk2(yb.z, yb.w); ((u32x2*)ob)[64 * j + lane] = o; }
        else { ((f32x4*)fa_)[64 * j + lane] = ya; ((f32x4*)fb_)[64 * j + lane] = yb; } }
}
__device__ __forceinline__ void hyena_unit(ldsp lds, const Args& a, const bf16* UT, const bf16* KRP, const bf16* KRS, bf16* YT, int unit, int tid, int wid, int lane) {
    const bool pr = unit < HW;
    const int c = pr ? unit : ((unit - HW) >> 1), half = pr ? 0 : ((unit - HW) & 1);
    const int L = pr ? L_P : L_S, Nb = L >> 5, nseq = pr ? 2 : 16;
    const int SP = (Nb + 64) * 64;
    const int HY_SOFF = 4 * L + 64;
    const bf16* KR = (pr ? KRP : KRS) + (size_t)c * (2 * L);
    { const int nz = (nseq * SP) >> 4; for (int i = tid; i < nz; i += 512) *(LAS v4u*)(lds + HY_SOFF + i * 16) = (v4u){0u, 0u, 0u, 0u};
      if (tid < 4) *(LAS v4u*)(lds + 4 * L + tid * 16) = (v4u){0u, 0u, 0u, 0u}; }
    { const int nc = (4 * L) >> 4; for (int i = tid; i < nc; i += 512) *(LAS v4u*)(lds + i * 16) = *(const v4u*)((const char*)KR + (size_t)i * 16); }
    __syncthreads();
    const float* cw = a.in[8]; const float* cb = a.in[9];
    {
        const float a0 = cw[HW + c], a1 = cw[1536 + HW + c], a2 = cw[3072 + HW + c], ab = cb[HW + c];
        const float v0 = cw[2 * HW + c], v1 = cw[1536 + 2 * HW + c], v2 = cw[3072 + 2 * HW + c], vb = cb[2 * HW + c];
        const int gps = L >> 3, total = nseq * gps;
        (void)total;
#pragma unroll
        for (int bt = 0; bt < 2; ++bt) {
            v4u r1[4], r2[4]; unsigned short h1m[4], h1p[4], h2m[4], h2p[4]; int tq[4], sq_[4];
#pragma unroll
            for (int q = 0; q < 4; ++q) {
                const int g = tid + 512 * (4 * bt + q); const int seq = g / gps, tg = g - seq * gps, t = tg << 3; tq[q] = t; sq_[q] = seq;
                const size_t tok = (size_t)(pr ? seq * L_P : T_P + (half * 16 + seq) * L_S) + t;
                const bf16* p1 = UT + (size_t)(HW + c) * TT + tok; const bf16* p2 = UT + (size_t)(2 * HW + c) * TT + tok;
                r1[q] = *(const v4u*)p1; r2[q] = *(const v4u*)p2;
                const int im = t > 0 ? -1 : 0, ip = t + 8 < L ? 8 : 7;
                h1m[q] = p1[im]; h2m[q] = p2[im]; h1p[q] = p1[ip]; h2p[q] = p2[ip];
            }
#pragma unroll
            for (int q = 0; q < 4; ++q) {
                const int t = tq[q], seq = sq_[q]; const v4u ra = r1[q], rb2 = r2[q];
                float x[10], y[10];
                x[0] = t > 0 ? bf2f(h1m[q]) : 0.f; y[0] = t > 0 ? bf2f(h2m[q]) : 0.f;
                x[9] = t + 8 < L ? bf2f(h1p[q]) : 0.f; y[9] = t + 8 < L ? bf2f(h2p[q]) : 0.f;
                x[1] = bflo(ra.x); x[2] = bfhi(ra.x); x[3] = bflo(ra.y); x[4] = bfhi(ra.y); x[5] = bflo(ra.z); x[6] = bfhi(ra.z); x[7] = bflo(ra.w); x[8] = bfhi(ra.w);
                y[1] = bflo(rb2.x); y[2] = bfhi(rb2.x); y[3] = bflo(rb2.y); y[4] = bfhi(rb2.y); y[5] = bflo(rb2.z); y[6] = bfhi(rb2.z); y[7] = bflo(rb2.w); y[8] = bfhi(rb2.w);
                float sv[8];
#pragma unroll
                for (int e = 0; e < 8; ++e) sv[e] = (a0 * x[e] + a1 * x[e + 1] + a2 * x[e + 2] + ab) * (v0 * y[e] + v1 * y[e + 1] + v2 * y[e + 2] + vb);
                v4u o; o.x = pk2(sv[0], sv[1]); o.y = pk2(sv[2], sv[3]); o.z = pk2(sv[4], sv[5]); o.w = pk2(sv[6], sv[7]);
                const int r = 32 + (t >> 5), ci = (t & 31) >> 3;
                *(LAS v4u*)(lds + HY_SOFF + seq * SP + r * 64 + ((ci ^ ((r >> 2) & 3)) << 4)) = o;
            }
        }
    }
    __syncthreads();
    const int n = lane & 31, hi = lane >> 5;
    const int i0 = pr ? 64 * wid : 0, sq0 = pr ? 0 : 2 * wid, sq1 = sq0 + 1;
    const unsigned sb0 = HY_SOFF + sq0 * SP, sb1 = HY_SOFF + sq1 * SP;
    f32x16 acc00 = {}, acc01 = {}, acc10 = {}, acc11 = {};
    unsigned Xd[2][5], Yd[2][5]; v4u Xb0[2][2], Xb1[2][2], Yb0[2][2], Yb1[2][2];
    const unsigned hy_sh = (unsigned)(n & 1) << 4, hy_ab = (unsigned)(((L - n + 8 * hi) >> 1) * 4); const int hy_rb = 32 + i0 + n;
#define HY_LOAD(dd, T0, T1, P) do { const int dq_ = (dd); \
        const LAS unsigned* fp = (const LAS unsigned*)(lds + (hy_ab - 64u * (unsigned)dq_)); \
        _Pragma("unroll") for (int kk = 0; kk < 2; ++kk) { P##d[kk][0] = fp[8 * kk]; P##d[kk][1] = fp[8 * kk + 1]; P##d[kk][2] = fp[8 * kk + 2]; P##d[kk][3] = fp[8 * kk + 3]; P##d[kk][4] = fp[8 * kk + 4]; } \
        const int r0_ = hy_rb - dq_; const unsigned off0_ = ((unsigned)r0_ << 6) + ((((unsigned)r0_ >> 2) & 3u) ^ (unsigned)hi) * 16u, off1_ = off0_ ^ 32u; \
        if (T0) { P##b0[0][0] = *(const LAS v4u*)(lds + sb0 + off0_); P##b0[0][1] = *(const LAS v4u*)(lds + sb1 + off0_); P##b0[1][0] = *(const LAS v4u*)(lds + sb0 + off1_); P##b0[1][1] = *(const LAS v4u*)(lds + sb1 + off1_); } \
        if (T1) { P##b1[0][0] = *(const LAS v4u*)(lds + sb0 + off0_ + 2048); P##b1[0][1] = *(const LAS v4u*)(lds + sb1 + off0_ + 2048); P##b1[1][0] = *(const LAS v4u*)(lds + sb0 + off1_ + 2048); P##b1[1][1] = *(const LAS v4u*)(lds + sb1 + off1_ + 2048); } } while (0)
#define HY_COMP(T0, T1, P) do { _Pragma("unroll") for (int kk = 0; kk < 2; ++kk) { const unsigned sh = hy_sh; v4u aw; \
        aw.x = __builtin_amdgcn_alignbit(P##d[kk][1], P##d[kk][0], sh); aw.y = __builtin_amdgcn_alignbit(P##d[kk][2], P##d[kk][1], sh); \
        aw.z = __builtin_amdgcn_alignbit(P##d[kk][3], P##d[kk][2], sh); aw.w = __builtin_amdgcn_alignbit(P##d[kk][4], P##d[kk][3], sh); \
        const bf16x8 A = __builtin_bit_cast(bf16x8, aw); \
        if (T0) { acc00 = __builtin_amdgcn_mfma_f32_32x32x16_bf16(A, __builtin_bit_cast(bf16x8, P##b0[kk][0]), acc00, 0, 0, 0); \
                  acc01 = __builtin_amdgcn_mfma_f32_32x32x16_bf16(A, __builtin_bit_cast(bf16x8, P##b0[kk][1]), acc01, 0, 0, 0); } \
        if (T1) { acc10 = __builtin_amdgcn_mfma_f32_32x32x16_bf16(A, __builtin_bit_cast(bf16x8, P##b1[kk][0]), acc10, 0, 0, 0); \
                  acc11 = __builtin_amdgcn_mfma_f32_32x32x16_bf16(A, __builtin_bit_cast(bf16x8, P##b1[kk][1]), acc11, 0, 0, 0); } } } while (0)
#define HY_SB() __builtin_amdgcn_sched_barrier(0)
#define HY_SEG(dlo, dhi, T0, T1) do { int d = (dlo); const int dh_ = (dhi); HY_LOAD(d, T0, T1, X); HY_SB(); \
        for (; d + 1 <= dh_; d += 2) { HY_LOAD(d + 1, T0, T1, Y); HY_SB(); HY_COMP(T0, T1, X); HY_SB(); \
            HY_LOAD((d + 2 <= dh_ ? d + 2 : dh_), T0, T1, X); HY_SB(); HY_COMP(T0, T1, Y); HY_SB(); } \
        if (d == dh_) { HY_COMP(T0, T1, X); HY_SB(); } } while (0)
    HY_SEG(i0 - Nb + 1, i0 + 32 - Nb, true, false);
    HY_SEG(i0 + 33 - Nb, i0 + 31, true, true);
    HY_SEG(i0 + 32, i0 + 63, false, true);
#undef HY_LOAD
#undef HY_COMP
#undef HY_SB
#undef HY_SEG
    {
        const float a0 = cw[c], a1 = cw[1536 + c], a2 = cw[3072 + c], ab = cb[c], hb = a.in[18][c];
#pragma unroll
        for (int ts = 0; ts < 4; ++ts) {
            const int tile = ts >> 1, sl = ts & 1; const f32x16 acc = ts == 0 ? acc00 : (ts == 1 ? acc01 : (ts == 2 ? acc10 : acc11));
            const int sq = sl ? sq1 : sq0; const int i = i0 + 32 * tile + n;
            const size_t tokb = (size_t)(pr ? sq * L_P : T_P + (half * 16 + sq) * L_S);
            const bf16* u0 = UT + (size_t)c * TT + tokb; bf16* yo = YT + (size_t)c * TT + tokb;
#pragma unroll
            for (int g4 = 0; g4 < 4; ++g4) {
                const int aa = 8 * g4 + 4 * hi, t = 32 * i + aa;
                const u32x2 ru = *(const u32x2*)(u0 + t);
                float x[6]; x[0] = t > 0 ? bf2f(u0[t - 1]) : 0.f; x[5] = t + 4 < L ? bf2f(u0[t + 4]) : 0.f;
                x[1] = bflo(ru.x); x[2] = bfhi(ru.x); x[3] = bflo(ru.y); x[4] = bfhi(ru.y);
                const int r = 32 + i, ci = aa >> 3;
                const u32x2 rs = *(const LAS u32x2*)(lds + HY_SOFF + sq * SP + r * 64 + ((ci ^ ((r >> 2) & 3)) << 4) + (aa & 7) * 2);
                const float s0 = bflo(rs.x), s1 = bfhi(rs.x), s2 = bflo(rs.y), s3 = bfhi(rs.y);
                const float y0 = (a0 * x[0] + a1 * x[1] + a2 * x[2] + ab) * (acc[4 * g4 + 0] + s0 * hb);
                const float y1 = (a0 * x[1] + a1 * x[2] + a2 * x[3] + ab) * (acc[4 * g4 + 1] + s1 * hb);
                const float y2 = (a0 * x[2] + a1 * x[3] + a2 * x[4] + ab) * (acc[4 * g4 + 2] + s2 * hb);
                const float y3 = (a0 * x[3] + a1 * x[4] + a2 * x[5] + ab) * (acc[4 * g4 + 3] + s3 * hb);
                u32x2 o; o.x = pk2(y0, y1); o.y = pk2(y2, y3); *(u32x2*)(yo + t) = o;
            }
        }
    }
    __syncthreads();
}

__device__ __forceinline__ void hnorm_phase(ldsp lds, const Args& a, const bf16* YT, bf16* MIX, int bx, int G, int tid, int wid, int lane) {
    LAS unsigned* tile = (LAS unsigned*)lds;
    const float* hw = a.in[19];
    constexpr int NIT = TT / 64;
    v4u pre[8];
    int it = bx;
    if (it < NIT) {
#pragma unroll
        for (int q = 0; q < 8; ++q) { const int idx = tid + 512 * q, c = idx >> 3, k = idx & 7; pre[q] = *(const v4u*)(YT + (size_t)c * TT + it * 64 + 8 * k); } }
    for (; it < NIT; it += G) {
        const int tok0 = it * 64;
#pragma unroll
        for (int q = 0; q < 8; ++q) { const int idx = tid + 512 * q, c = idx >> 3, k = idx & 7; LAS unsigned* p = tile + c * 33 + 4 * k; p[0] = pre[q].x; p[1] = pre[q].y; p[2] = pre[q].z; p[3] = pre[q].w; }
        __syncthreads();
        if (it + G < NIT) {
#pragma unroll
            for (int q = 0; q < 8; ++q) { const int idx = tid + 512 * q, c = idx >> 3, k = idx & 7; pre[q] = *(const v4u*)(YT + (size_t)c * TT + (it + G) * 64 + 8 * k); } }
        for (int tt = wid * 8; tt < wid * 8 + 8; ++tt) {
            float v[8]; float ss = 0.f;
#pragma unroll
            for (int e = 0; e < 8; ++e) { const unsigned w = tile[(e * 64 + lane) * 33 + (tt >> 1)]; v[e] = (tt & 1) ? bfhi(w) : bflo(w); ss += v[e] * v[e]; }
            const float r = 1.f / sqrtf(wave_sum(ss) * (1.f / HW) + 1e-6f);
            bf16* orow = MIX + (size_t)(tok0 + tt) * D;
#pragma unroll
            for (int e = 0; e < 8; ++e) orow[e * 64 + lane] = (bf16)f2bf(v[e] * r * hw[e * 64 + lane]);
        }
        __syncthreads();
    }
}

constexpr int AT_KP = 272, AT_VP = 144, AT_KB = 64 * AT_KP, AT_VB = 128 * AT_VP, AT_V0 = 2 * AT_KB, AT_EX = 2 * AT_KB + 2 * AT_VB, AT_EXP = 132;
typedef float f32x2 __attribute__((ext_vector_type(2)));
typedef __bf16 at_bf16x2 __attribute__((ext_vector_type(2)));
__device__ __forceinline__ unsigned at_cvtpk(f32x2 v) { return __builtin_bit_cast(unsigned, __builtin_convertvector(v, at_bf16x2)); }
#define AT_BAR() do { asm volatile("s_waitcnt lgkmcnt(0)" ::: "memory"); __builtin_amdgcn_s_barrier(); asm volatile("" ::: "memory"); } while (0)
__device__ __forceinline__ void attn_unit(ldsp lds, const bf16* QK, const bf16* VT, bf16* MIX, const float* subln, float lam, int tokbase, int L, int h, int qb, int tid, int wid, int lane) {
    const int n = lane & 31, hi = lane >> 5, j = wid >> 2, g = wid & 3;
    const int q0 = qb * 128 + g * 32;
    bf16x8 qf[4];
    { const bf16* qp = QK + (size_t)(tokbase + q0 + n) * D + (2 * h + j) * 64 + hi * 8;
#pragma unroll
      for (int kk = 0; kk < 4; ++kk) qf[kk] = *(const bf16x8*)(qp + 16 * kk); }
#define qf_(kk) qf[kk]
    const int kkey0 = tid >> 4, kc = tid & 15;
    const int vdv0 = tid >> 3, vc = tid & 7;
    const __amdgpu_buffer_rsrc_t rk = __builtin_amdgcn_make_buffer_rsrc((void*)(QK + (size_t)tokbase * D), (short)0, L * 2048, 0x00020000);
    const __amdgpu_buffer_rsrc_t rv = __builtin_amdgcn_make_buffer_rsrc((void*)(VT + (size_t)(h * 128) * TT + tokbase), (short)0, 128 * TT * 2, 0x00020000);
    const int kvo0 = kkey0 * 2048 + (512 + h * 128 + kc * 8) * 2, kvo1 = kvo0 + 32 * 2048, vvo0 = vdv0 * (TT * 2) + vc * 16, vvo1 = vvo0 + 64 * (TT * 2);
    const unsigned klo = kkey0 * AT_KP + kc * 16, vlo = AT_V0 + vdv0 * AT_VP + (vc >> 1) * 32 + (vc & 1) * 8;
    const int NT = L >> 6;
    v4u kr0, kr1, vr0, vr1;
#define AT_BL(r, vo, so) __builtin_bit_cast(v4u, __builtin_amdgcn_raw_buffer_load_b128(r, vo, so, 0))
#define AT_LDK(t) do { const int so_ = (t) * 131072; kr0 = AT_BL(rk, kvo0, so_); kr1 = AT_BL(rk, kvo1, so_); } while (0)
#define AT_LDV(t) do { const int so_ = (t) * 128; vr0 = AT_BL(rv, vvo0, so_); vr1 = AT_BL(rv, vvo1, so_); } while (0)
#define AT_WRK(t) do { const unsigned bo = ((t) & 1) * AT_KB; *(LAS v4u*)(lds + bo + klo) = kr0; *(LAS v4u*)(lds + bo + klo + 32 * AT_KP) = kr1; } while (0)
#define AT_WRV(t) do { const unsigned bo = ((t) & 1) * AT_VB; *(LAS u32x2*)(lds + bo + vlo) = (u32x2){vr0.x, vr0.y}; *(LAS u32x2*)(lds + bo + vlo + 16) = (u32x2){vr0.z, vr0.w}; \
        *(LAS u32x2*)(lds + bo + vlo + 64 * AT_VP) = (u32x2){vr1.x, vr1.y}; *(LAS u32x2*)(lds + bo + vlo + 64 * AT_VP + 16) = (u32x2){vr1.z, vr1.w}; } while (0)
#define AT_MF(a, b, c) __builtin_amdgcn_mfma_f32_32x32x16_bf16(a, b, c, 0, 0, 0)
#define AT_B8(x) __builtin_bit_cast(bf16x8, x)
    AT_LDK(0); vr0 = AT_BL(rk, kvo0, 131072); vr1 = AT_BL(rk, kvo1, 131072);
    AT_WRK(0); *(LAS v4u*)(lds + AT_KB + klo) = vr0; *(LAS v4u*)(lds + AT_KB + klo + 32 * AT_KP) = vr1;
    for (int i = tid; i < AT_VB / 16; i += 512) *(LAS v4u*)(lds + AT_V0 + AT_VB + i * 16) = (v4u){0u, 0u, 0u, 0u};
    AT_BAR();
    f32x16 o[4] = {}; float m_reg = -1e30f, l_reg = 0.f;
    constexpr float C = 0.125f * 1.4426950408889634f;
    const unsigned kro = n * AT_KP + j * 128 + hi * 16, vro = AT_V0 + n * AT_VP + hi * 16;
    f32x16 sa0, sa1, sb0, sb1; bf16x8 pba[4] = {}, pbb[4] = {};
    {
        const unsigned kb = kro;
        sa0 = AT_MF(*(const LAS bf16x8*)(lds + kb), qf_(0), (f32x16){}); sa1 = AT_MF(*(const LAS bf16x8*)(lds + kb + 32 * AT_KP), qf_(0), (f32x16){});
#pragma unroll
        for (int kk = 1; kk < 4; ++kk) { sa0 = AT_MF(*(const LAS bf16x8*)(lds + kb + kk * 32), qf_(kk), sa0); sa1 = AT_MF(*(const LAS bf16x8*)(lds + kb + 32 * AT_KP + kk * 32), qf_(kk), sa1); }
    }
#define AT_SB() __builtin_amdgcn_sched_barrier(0)
#define AT_SPV(c, SP0, SP1) ((((c) >> 2) < 2) ? (f32x2){SP0[8 * (((c) >> 2) & 1) + 2 * ((c) & 3)], SP0[8 * (((c) >> 2) & 1) + 2 * ((c) & 3) + 1]} : (f32x2){SP1[8 * (((c) >> 2) & 1) + 2 * ((c) & 3)], SP1[8 * (((c) >> 2) & 1) + 2 * ((c) & 3) + 1]})
#define AT_FMA(c, SP0, SP1) do { const f32x2 sp_ = AT_SPV(c, SP0, SP1); float a_ = fmaf(sp_.x, C, mC_); asm volatile("" : "+v"(a_)); const float b_ = fmaf(sp_.y, C, mC_); xs_[(c) & 1] = (f32x2){a_, b_}; } while (0)
#define AT_EXP(c) do { ev_[(c) & 1].x = __builtin_amdgcn_exp2f(xs_[(c) & 1].x); ev_[(c) & 1].y = __builtin_amdgcn_exp2f(xs_[(c) & 1].y); } while (0)
#define AT_ACC(c) do { ps0_ += ev_[(c) & 1].x; ps1_ += ev_[(c) & 1].y; asm volatile("" : "+v"(ps0_), "+v"(ps1_)); wn_[(c) >> 2][(c) & 3] = at_cvtpk(ev_[(c) & 1]); } while (0)
#define AT_VF(dt, s_) (*(const LAS v4u*)(lds + vb_ + (dt) * 32 * AT_VP + (s_) * 32))
#define AT_KF(kk, hf) (*(const LAS v4u*)(lds + kb_ + (hf) * 32 * AT_KP + (kk) * 32))
#define AT_ITER(t, SP0, SP1, SQ0, SQ1, PBO, PBN) do { \
        const unsigned kb_ = (((t) + 1) & 1) * AT_KB + kro, vb_ = (((t) + 1) & 1) * AT_VB + vro; \
        v4u fa[4], fb[4], wn_[4]; f32x2 xs_[2], ev_[2]; float ps0_ = 0.f, ps1_ = 0.f; \
        fa[0] = AT_VF(0, 0); fa[1] = AT_VF(0, 1); fa[2] = AT_VF(0, 2); fa[3] = AT_VF(0, 3); \
        float pmax_ = fmaxf(SP0[0], SP1[0]); \
        _Pragma("unroll") for (int r = 1; r < 16; ++r) pmax_ = fmaxf(fmaxf(pmax_, SP0[r]), SP1[r]); \
        pmax_ = fmaxf(pmax_, __shfl_xor(pmax_, 32)); \
        const bool need_ = !__all((pmax_ - m_reg) * C <= 8.0f);     \
        const float mn_ = need_ ? fmaxf(m_reg, pmax_) : m_reg, mC_ = -mn_ * C; \
        AT_FMA(0, SP0, SP1); \
        AT_SB(); \
        o[0] = AT_MF(AT_B8(fa[0]), PBO[0], o[0]); fb[0] = AT_VF(1, 0); { const int tk_ = (t) + 2 < NT ? (t) + 2 : NT - 1; AT_LDK(tk_); } AT_EXP(0); AT_FMA(1, SP0, SP1); AT_SB(); \
        o[0] = AT_MF(AT_B8(fa[1]), PBO[1], o[0]); fb[1] = AT_VF(1, 1); AT_LDV(t); AT_EXP(1); AT_ACC(0); AT_FMA(2, SP0, SP1); AT_SB(); \
        o[0] = AT_MF(AT_B8(fa[2]), PBO[2], o[0]); fb[2] = AT_VF(1, 2); AT_EXP(2); AT_ACC(1); AT_FMA(3, SP0, SP1); AT_SB(); \
        o[0] = AT_MF(AT_B8(fa[3]), PBO[3], o[0]); fb[3] = AT_VF(1, 3); AT_EXP(3); AT_ACC(2); AT_FMA(4, SP0, SP1); AT_SB(); \
        o[1] = AT_MF(AT_B8(fb[0]), PBO[0], o[1]); fa[0] = AT_VF(2, 0); AT_EXP(4); AT_ACC(3); AT_FMA(5, SP0, SP1); AT_SB(); \
        o[1] = AT_MF(AT_B8(fb[1]), PBO[1], o[1]); fa[1] = AT_VF(2, 1); AT_EXP(5); AT_ACC(4); AT_FMA(6, SP0, SP1); AT_SB(); \
        o[1] = AT_MF(AT_B8(fb[2]), PBO[2], o[1]); fa[2] = AT_VF(2, 2); AT_EXP(6); AT_ACC(5); AT_FMA(7, SP0, SP1); AT_SB(); \
        o[1] = AT_MF(AT_B8(fb[3]), PBO[3], o[1]); fa[3] = AT_VF(2, 3); AT_EXP(7); AT_ACC(6); AT_FMA(8, SP0, SP1); AT_SB(); \
        o[2] = AT_MF(AT_B8(fa[0]), PBO[0], o[2]); fb[0] = AT_VF(3, 0); AT_EXP(8); AT_ACC(7); AT_FMA(9, SP0, SP1); AT_SB(); \
        o[2] = AT_MF(AT_B8(fa[1]), PBO[1], o[2]); fb[1] = AT_VF(3, 1); AT_EXP(9); AT_ACC(8); AT_FMA(10, SP0, SP1); AT_SB(); \
        o[2] = AT_MF(AT_B8(fa[2]), PBO[2], o[2]); fb[2] = AT_VF(3, 2); AT_EXP(10); AT_ACC(9); AT_FMA(11, SP0, SP1); AT_SB(); \
        o[2] = AT_MF(AT_B8(fa[3]), PBO[3], o[2]); fb[3] = AT_VF(3, 3); AT_EXP(11); AT_ACC(10); AT_FMA(12, SP0, SP1); AT_SB(); \
        o[3] = AT_MF(AT_B8(fb[0]), PBO[0], o[3]); fa[0] = AT_KF(0, 0); AT_EXP(12); AT_ACC(11); AT_FMA(13, SP0, SP1); AT_SB(); \
        o[3] = AT_MF(AT_B8(fb[1]), PBO[1], o[3]); fa[1] = AT_KF(0, 1); AT_EXP(13); AT_ACC(12); AT_FMA(14, SP0, SP1); AT_SB(); \
        o[3] = AT_MF(AT_B8(fb[2]), PBO[2], o[3]); fa[2] = AT_KF(1, 0); AT_EXP(14); AT_ACC(13); AT_FMA(15, SP0, SP1); AT_SB(); \
        o[3] = AT_MF(AT_B8(fb[3]), PBO[3], o[3]); fa[3] = AT_KF(1, 1); bf16x8 qa_ = qf_(0); AT_EXP(15); AT_ACC(14); AT_SB(); \
        SQ0 = AT_MF(AT_B8(fa[0]), qa_, (f32x16){}); fb[0] = AT_KF(2, 0); AT_ACC(15); AT_SB(); \
        SQ1 = AT_MF(AT_B8(fa[1]), qa_, (f32x16){}); fb[1] = AT_KF(2, 1); bf16x8 qb_ = qf_(1); AT_SB(); \
        SQ0 = AT_MF(AT_B8(fa[2]), qb_, SQ0); fb[2] = AT_KF(3, 0); AT_SB(); \
        SQ1 = AT_MF(AT_B8(fa[3]), qb_, SQ1); fb[3] = AT_KF(3, 1); qa_ = qf_(2); AT_SB(); \
        SQ0 = AT_MF(AT_B8(fb[0]), qa_, SQ0); AT_WRK(t); AT_WRV(t); AT_SB();     \
        SQ1 = AT_MF(AT_B8(fb[1]), qa_, SQ1); qb_ = qf_(3); AT_SB(); \
        SQ0 = AT_MF(AT_B8(fb[2]), qb_, SQ0); AT_SB(); \
        SQ1 = AT_MF(AT_B8(fb[3]), qb_, SQ1); AT_SB(); \
        PBN[0] = AT_B8(wn_[0]); PBN[1] = AT_B8(wn_[1]); PBN[2] = AT_B8(wn_[2]); PBN[3] = AT_B8(wn_[3]); \
        if (need_) { const float alpha_ = __builtin_amdgcn_exp2f((m_reg - mn_) * C); l_reg *= alpha_; _Pragma("unroll") for (int dt = 0; dt < 4; ++dt) o[dt] = o[dt] * alpha_; } \
        l_reg += ps0_ + ps1_; m_reg = mn_; \
        AT_BAR(); \
    } while (0)
    for (int t = 0; t < NT; t += 2) {
        AT_ITER(t, sa0, sa1, sb0, sb1, pba, pbb);
        AT_ITER(t + 1, sb0, sb1, sa0, sa1, pbb, pba);
    }
    {
        const unsigned vb_ = AT_VB + vro;
#pragma unroll
        for (int dt = 0; dt < 4; ++dt)
#pragma unroll
            for (int s_ = 0; s_ < 4; ++s_) { const v4u aw = *(const LAS v4u*)(lds + vb_ + dt * 32 * AT_VP + s_ * 32);
                o[dt] = AT_MF(AT_B8(aw), pba[s_], o[dt]); }
    }
    AT_BAR();
#undef AT_BL
#undef AT_LDK
#undef AT_LDV
#undef AT_WRK
#undef AT_WRV
#undef AT_MF
#undef AT_B8
#undef AT_SB
#undef AT_SPV
#undef AT_FMA
#undef AT_EXP
#undef AT_ACC
#undef AT_VF
#undef AT_KF
#undef AT_ITER
#undef qf_
    const float linv = 1.f / (l_reg + __shfl_xor(l_reg, 32));
    LAS float* ex = (LAS float*)(lds + AT_EX) + (size_t)(g * 32 + n) * AT_EXP;
    if (j == 1) {
        const float sc = linv * lam;
#pragma unroll
        for (int t = 0; t < 4; ++t)
#pragma unroll
            for (int r4 = 0; r4 < 4; ++r4) { const int dv = 32 * t + 8 * r4 + 4 * hi;
                *(LAS f32x4*)(ex + dv) = (f32x4){o[t][4 * r4] * sc, o[t][4 * r4 + 1] * sc, o[t][4 * r4 + 2] * sc, o[t][4 * r4 + 3] * sc}; }
    }
    __syncthreads();
    if (j == 0) {
        float ss = 0.f;
#pragma unroll
        for (int t = 0; t < 4; ++t)
#pragma unroll
            for (int r4 = 0; r4 < 4; ++r4) { const int dv = 32 * t + 8 * r4 + 4 * hi; const f32x4 e = *(const LAS f32x4*)(ex + dv);
#pragma unroll
                for (int k = 0; k < 4; ++k) { const float v = o[t][4 * r4 + k] * linv - e[k]; o[t][4 * r4 + k] = v; ss += v * v; } }
        ss += __shfl_xor(ss, 32);
        const float rs = 0.8f / sqrtf(ss * (1.f / 128.f) + 1e-5f);
        bf16* orow = MIX + (size_t)(tokbase + q0 + n) * D + 512 + h * 128;
#pragma unroll
        for (int t = 0; t < 4; ++t)
#pragma unroll
            for (int p2 = 0; p2 < 2; ++p2) {
                u32x2 eo[2];
#pragma unroll
                for (int q = 0; q < 2; ++q) { const int r4 = 2 * p2 + q, dv = 32 * t + 8 * r4 + 4 * hi; const f32x4 w = *(const f32x4*)(subln + dv);
                    eo[q].x = pk2(o[t][4 * r4] * rs * w.x, o[t][4 * r4 + 1] * rs * w.y); eo[q].y = pk2(o[t][4 * r4 + 2] * rs * w.z, o[t][4 * r4 + 3] * rs * w.w); }
                const auto sx = __builtin_amdgcn_permlane32_swap(eo[0].x, eo[1].x, false, false), sy = __builtin_amdgcn_permlane32_swap(eo[0].y, eo[1].y, false, false);
                const v4u ov = {sx[0], sy[0], sx[1], sy[1]};
                *(v4u*)(orow + 32 * t + 8 * (2 * p2 + hi)) = ov; }
    }
    __syncthreads();
}
__global__ void __launch_bounds__(512, 2) hymba_fwd(Args a) {
    extern __shared__ __attribute__((aligned(16))) unsigned char lds_raw[];
    cg::grid_group grid = cg::this_grid();
    const ldsp lds = (ldsp)lds_raw;
    const int tid = threadIdx.x, lane = tid & 63, wid = __builtin_amdgcn_readfirstlane(tid >> 6);
    const int G = gridDim.x, bx = blockIdx.x, gw = bx * 8 + wid, NGW = G * 8;
    unsigned char* ws = a.ws;
    bf16* WIN = (bf16*)(ws + WS_WIN); bf16* WOUT = (bf16*)(ws + WS_WOUT); bf16* W1 = (bf16*)(ws + WS_W1); bf16* W2 = (bf16*)(ws + WS_W2);
    float* MOD = (float*)(ws + WS_MOD); float* ROT = (float*)(ws + WS_ROT); bf16* KRP = (bf16*)(ws + WS_KRP); bf16* KRS = (bf16*)(ws + WS_KRS);
    bf16* XN = (bf16*)(ws + WS_XN); bf16* UT = (bf16*)(ws + WS_UT); bf16* QK = (bf16*)(ws + WS_QK); bf16* VT = (bf16*)(ws + WS_VT); bf16* YT = (bf16*)(ws + WS_YT);
    bf16* HB = (bf16*)(ws + WS_H); bf16* MIX = XN;
    const int lo = a.ph_lo, hi_ = a.ph_hi;
#ifndef PHMASK
#define PHMASK 0xffffffffu
#endif
#define IN(k) (((PHMASK >> ((k) < PH_MLP0 ? (k) : ((k) == PH_FINAL ? 9 : 7 + (((k) - PH_MLP0) & 1)))) & 1u) && lo <= (k) && (k) < hi_)
#define SEAM(k) do { if (IN(k) && IN((k) + 1)) grid.sync(); } while (0)

    if (IN(PH_P0)) {
#ifndef P0_NO_ADALN
        for (int it = bx; it < 6144 / 64; it += G) adaln_item(lds, a, MOD, it, tid, wid, lane);
#endif
        LAS float* scr = (LAS float*)(lds + wid * 16384);
        constexpr int I_IN = (D / 64) * (DIN / 32), I_O = (D / 64) * (D / 32), I_1 = (D / 64) * (FF / 32), I_2 = (FF / 64) * (D / 32), NTR = I_IN + I_O + I_1 + I_2;
        constexpr int I_FP = L_P / 32, I_FS = L_S / 32;
#ifndef P0_NO_FILT
        for (int it = NGW - 1 - gw; it < 3 * (I_FP + I_FS); it += NGW) { const int q = it / 3, part = it - 3 * q, np0 = part == 0 ? 0 : (part == 1 ? 6 : 11), npn = part == 0 ? 6 : 5;
            if (q < I_FP) filter_item32(a, L_P, KRP, 32 * q, np0, npn, lane); else filter_item32(a, L_S, KRS, 32 * (q - I_FP), np0, npn, lane); }
#endif
        for (int it = gw; it < NTR; it += NGW) {
            int r = it;
            if (r < I_IN) { p0_transpose_item(a.in[7], D, DIN, WIN, 0, scr, r, lane); continue; } r -= I_IN;
            if (r < I_O) { p0_transpose_item(a.in[25], D, D, WOUT, 0, scr, r, lane); continue; } r -= I_O;
            if (r < I_1) { p0_transpose_item(a.in[27], D, FF, W1, 0, scr, r, lane); continue; } r -= I_1;
            p0_transpose_item(a.in[28], FF, D, W2, 0, scr, r, lane);
        }
#ifndef P0_NO_ROT
        for (int idx = bx * 512 + tid; idx < L_P * 8; idx += G * 512) { const int pos = idx >> 3, i = idx & 7;
            const float invf = powf(500000.0f, -(float)i / 8.0f); const float ang = (float)pos * invf;
            ROT[pos * 16 + i] = (float)cos((double)ang); ROT[pos * 16 + 8 + i] = (float)sin((double)ang); }
#endif
    }
    SEAM(PH_P0);
    if (IN(PH_XN1)) {
        for (int row = gw; row < TT; row += 2 * NGW) { const int rb_ = row + NGW; const int mb = batch_of_row(row); const float* xr = row < T_P ? a.in[0] + (size_t)row * D : a.in[1] + (size_t)(row - T_P) * D;
            if (rb_ < TT) { const int mb2 = batch_of_row(rb_); const float* xr2 = rb_ < T_P ? a.in[0] + (size_t)rb_ * D : a.in[1] + (size_t)(rb_ - T_P) * D;
                norm_row2<0>(xr, xr2, a.in[6], MOD + mb * 6144 + 1024, MOD + mb * 6144, MOD + mb2 * 6144 + 1024, MOD + mb2 * 6144, XN + (size_t)row * D, XN + (size_t)rb_ * D, nullptr, nullptr, 1e-6f, lane); }
            else norm_row<0>(xr, a.in[6], MOD + mb * 6144 + 1024, MOD + mb * 6144, XN + (size_t)row * D, nullptr, 1e-6f, lane); }
    }
    SEAM(PH_XN1);
    if (IN(PH_INPROJ)) {
        { pg8::Gemm g{WIN, XN, 1536, TT, D}; pg8::StaticOrder S; S.init(1536, TT, G, bx); pg8::EpiBf16<0, false> E{UT, TT, nullptr};
          pg8::gemm_phase<pg8::EpiBf16<0, false>, pg8::StaticOrder, PG8_ALIGN, PG8_SP2>(lds, g, S, E); }
        __syncthreads();
        { pg8::Gemm g{XN, WIN + (size_t)1536 * D, TT, 1024, D}; pg8::StaticOrder S; S.init(TT, 1024, G, bx); pg8::EpiBf16<0, true> E{QK, 1024, ROT};
          pg8::gemm_phase<pg8::EpiBf16<0, true>, pg8::StaticOrder, PG8_ALIGN, PG8_SP2>(lds, g, S, E); }
        __syncthreads();
        { pg8::Gemm g{WIN + (size_t)2560 * D, XN, 512, TT, D}; pg8::StaticOrder S; S.init(512, TT, G, bx); pg8::EpiBf16<0, false> E{VT, TT, nullptr};
          pg8::gemm_phase<pg8::EpiBf16<0, false>, pg8::StaticOrder, PG8_ALIGN, PG8_SP2>(lds, g, S, E); }
    }
    SEAM(PH_INPROJ);
    if (IN(PH_MIX)) {
        for (int u = bx; u < HW + 2 * HW; u += G) hyena_unit(lds, a, UT, KRP, KRS, YT, u, tid, wid, lane);
        const float lam = expf(wave_sum(a.in[20][lane] * a.in[21][lane])) - expf(wave_sum(a.in[22][lane] * a.in[23][lane])) + 0.2f;
        for (int u = bx; u < 1024 + 2048; u += G) {
            int mb, h, qb, tokbase, L;
            if (G == 256) {
                const int x = bx & 7, c = bx >> 3, r = u >> 8;
                if (r < 4) { mb = x >> 2; h = x & 3; qb = c + 32 * r; tokbase = mb * L_P; L = L_P; }
                else { const int w = c + 32 * (r - 4), p = (w >> 4) * 8 + x; mb = p >> 2; h = p & 3; qb = w & 15; tokbase = T_P + mb * L_S; L = L_S; }
            } else if (u < 1024) { mb = u >> 9; h = (u >> 7) & 3; qb = u & 127; tokbase = mb * L_P; L = L_P; }
            else { const int v = u - 1024; mb = v >> 6; h = (v >> 4) & 3; qb = v & 15; tokbase = T_P + mb * L_S; L = L_S; }
            attn_unit(lds, QK, VT, MIX, a.in[24], lam, tokbase, L, h, qb, tid, wid, lane);
        }
    }
    SEAM(PH_MIX);
    if (IN(PH_HNORM)) hnorm_phase(lds, a, YT, MIX, bx, G, tid, wid, lane);
    SEAM(PH_HNORM);
    if (IN(PH_OUTPROJ)) {
        pg8::Gemm g{MIX, WOUT, TT, D, D}; pg8::StaticOrder S; S.init(TT, D, G, bx); pg8::EpiGateRes E{a.in[0], a.in[1], a.out, MOD + 2048, 0};
        pg8::gemm_phase<pg8::EpiGateRes, pg8::StaticOrder, PG8_ALIGN, PG8_SP2>(lds, g, S, E);
    }
    SEAM(PH_OUTPROJ);
    if (IN(PH_XN2)) {
        for (int row = gw; row < TT; row += 2 * NGW) { const int rb_ = row + NGW; const int mb = batch_of_row(row);
            if (rb_ < TT) { const int mb2 = batch_of_row(rb_);
                norm_row2<0>(a.out + (size_t)row * D, a.out + (size_t)rb_ * D, a.in[26], MOD + mb * 6144 + 4096, MOD + mb * 6144 + 3072, MOD + mb2 * 6144 + 4096, MOD + mb2 * 6144 + 3072, XN + (size_t)row * D, XN + (size_t)rb_ * D, nullptr, nullptr, 1e-6f, lane); }
            else norm_row<0>(a.out + (size_t)row * D, a.in[26], MOD + mb * 6144 + 4096, MOD + mb * 6144 + 3072, XN + (size_t)row * D, nullptr, 1e-6f, lane); }
    }
    SEAM(PH_XN2);
    for (int ch = 0; ch < N_CHUNK; ++ch) {
        if (IN(PH_MLP0 + 2 * ch)) {
            pg8::Gemm g{XN + (size_t)ch * MLP_CHUNK * D, W1, MLP_CHUNK, FF, D}; pg8::StaticOrder S; S.init(MLP_CHUNK, FF, G, bx); pg8::EpiBf16<2, false> E{HB, FF, nullptr};
            pg8::gemm_phase<pg8::EpiBf16<2, false>, pg8::StaticOrder, PG8_ALIGN, PG8_SP2>(lds, g, S, E);
        }
        SEAM(PH_MLP0 + 2 * ch);
        if (IN(PH_MLP0 + 2 * ch + 1)) {
            pg8::Gemm g{HB, W2, MLP_CHUNK, D, FF}; pg8::StaticOrder S; S.init(MLP_CHUNK, D, G, bx); pg8::EpiGateRes E{nullptr, nullptr, a.out, MOD + 5120, ch * MLP_CHUNK};
            pg8::gemm_phase<pg8::EpiGateRes, pg8::StaticOrder, PG8_ALIGN, PG8_SP2>(lds, g, S, E);
        }
        SEAM(PH_MLP0 + 2 * ch + 1);
    }
    if (IN(PH_FINAL)) {
        for (int row = gw; row < TT; row += 2 * NGW) { const int rb_ = row + NGW;
            if (rb_ < TT) norm_row2<1>(a.out + (size_t)row * D, a.out + (size_t)rb_ * D, a.in[29], nullptr, nullptr, nullptr, nullptr, nullptr, nullptr, a.out + (size_t)row * D, a.out + (size_t)rb_ * D, 1e-6f, lane);
            else norm_row<1>(a.out + (size_t)row * D, a.in[29], nullptr, nullptr, nullptr, a.out + (size_t)row * D, 1e-6f, lane); }
    }
#undef IN
#undef SEAM
}

#ifndef MK_PER_PHASE
#define MK_PER_PHASE 0
#endif
extern "C" void kernel_launch(void* const* d_in, const int* in_sizes, int n_in, void* d_out, int out_size, void* d_ws, size_t ws_size, hipStream_t stream) {
    static int grid = 0;
    if (grid == 0) {
        if (n_in != 30 || out_size != TT * D || ws_size < WS_END) { fprintf(stderr, "kernel_launch: unexpected shapes (n_in %d out %d ws %zu)\n", n_in, out_size, ws_size); grid = -1; return; }
        int dev = 0, cus = 0, per_cu = 0;
        hipGetDevice(&dev); hipDeviceGetAttribute(&cus, hipDeviceAttributeMultiprocessorCount, dev);
        if (hipFuncSetAttribute((const void*)hymba_fwd, hipFuncAttributeMaxDynamicSharedMemorySize, LDS_BYTES) != hipSuccess) { fprintf(stderr, "kernel_launch: hipFuncSetAttribute failed\n"); grid = -1; return; }
        if (hipOccupancyMaxActiveBlocksPerMultiprocessor(&per_cu, (const void*)hymba_fwd, 512, LDS_BYTES) != hipSuccess || per_cu < 1) { fprintf(stderr, "kernel_launch: occupancy query says %d\n", per_cu); per_cu = 1; }
        (void)hipGetLastError();
        grid = cus * per_cu;
    }
    if (grid < 0) return;
    Args a{};
    for (int i = 0; i < 30; ++i) a.in[i] = (const float*)d_in[i];
    a.out = (float*)d_out; a.ws = (unsigned char*)d_ws;
#if MK_PER_PHASE
    for (int p = 0; p < N_PHASES; ++p) { a.ph_lo = p; a.ph_hi = p + 1; void* args[] = {&a};
        hipError_t e = hipLaunchCooperativeKernel((const void*)hymba_fwd, dim3(grid), dim3(512), args, LDS_BYTES, stream);
        if (e != hipSuccess) { fprintf(stderr, "launch %d failed: %s\n", p, hipGetErrorString(e)); break; } }
#else
    a.ph_lo = 0; a.ph_hi = N_PHASES; void* args[] = {&a};
    hipError_t e = hipLaunchCooperativeKernel((const void*)hymba_fwd, dim3(grid), dim3(512), args, LDS_BYTES, stream);
    if (e != hipSuccess) fprintf(stderr, "cooperative launch failed: %s (grid %d)\n", hipGetErrorString(e), grid);
#endif
}
```

```cpp
#include <hip/hip_runtime.h>
#include <hip/hip_cooperative_groups.h>
#include <cstdio>
#include <cstdint>
namespace cg = cooperative_groups;
namespace pg8 {
#define PG8_LAS __attribute__((address_space(3)))
typedef unsigned short bf16_t;
typedef short bf16x8 __attribute__((ext_vector_type(8)));
typedef float f32x4 __attribute__((ext_vector_type(4)));
typedef unsigned u32x4 __attribute__((ext_vector_type(4)));
constexpr int BM = 256, BK = 64, HALF = 128, HTB = HALF * BK * 2  , STAGE_BYTES = 8 * HTB, NXCD = 8, WGM = 8;

__host__ __device__ __forceinline__ int lds_byte(int r, int c) { const int st = (r >> 4) * 2 + (c >> 5), rr = r & 15, cc = c & 31, ob = rr * 64 + cc * 2; return st * 1024 + (ob ^ (((ob >> 9) & 1) << 5)); }
__host__ __device__ __forceinline__ void stage_rc(int b, int& R, int& C) { const int st = b / 1024, sb = b % 1024, swz = sb ^ (((sb >> 9) & 1) << 5); R = (st >> 1) * 16 + swz / 64; C = (st & 1) * 32 + (swz % 64) / 2; }
__host__ __device__ __forceinline__ int perm32(int rho) { const int n = rho >> 4, i = rho & 15; return 8 * (i >> 2) + 4 * n + (i & 3); }

struct Unit { int pm, pn; };
struct Gemm { const bf16_t* A; const bf16_t* Bt; int M, N, K; };

struct StaticOrder {
    int nM, nN, nwg, G, c;
    __host__ __device__ void init(int M, int N, int G_, int c_) { nM = M / BM; nN = N / BM; nwg = nM * nN; G = G_; c = c_; }
    __host__ __device__ bool next(int i, Unit& u) const {
        const long L = (long)i * G + c; if (L >= nwg) return false;
        int wgid = (int)L; { const int q = nwg / NXCD, r = nwg % NXCD, xcd = wgid % NXCD, off = wgid / NXCD; wgid = (xcd < r ? xcd * (q + 1) : r * (q + 1) + (xcd - r) * q) + off; }
        const int nig = WGM * nN, gid = wgid / nig, fm = gid * WGM, gsz = (nM - fm) < WGM ? (nM - fm) : WGM;
        u.pm = fm + ((wgid % nig) % gsz); u.pn = (wgid % nig) / gsz; return true;
    }
    __device__ __forceinline__ void a_ready(const Unit&) const {}
    __device__ __forceinline__ void done(const Unit&) const {}
};

typedef __bf16 pg8_bf16x2 __attribute__((ext_vector_type(2))); typedef float pg8_f32x2 __attribute__((ext_vector_type(2)));
__device__ __forceinline__ unsigned cvt_pk_bf16(float lo, float hi) { const pg8_f32x2 v = {lo, hi}; return __builtin_bit_cast(unsigned, __builtin_convertvector(v, pg8_bf16x2)); }
template <int ACT, bool ROT> struct EpiBf16 {
    static constexpr bool PERM = true, AFTER_DRAIN = false;
    bf16_t* O; int ldc; const float* rot;
    __device__ __forceinline__ void operator()(const f32x4 (&acc)[2][2][4][2], const Unit& u, int wr, int wc, int fr, int fq) const {
        const int row0 = u.pm * BM + wr * 64 + fr;
        const int col0 = u.pn * BM + wc * 32 + 8 * fq;
#pragma unroll
        for (int ai = 0; ai < 2; ++ai)
#pragma unroll
            for (int m = 0; m < 4; ++m) {
                const int row = row0 + ai * HALF + m * 16;
                bf16_t* rowp = O + (size_t)row * ldc + col0;
                f32x4 c0 = {1.f, 1.f, 1.f, 1.f}, c1 = c0, s0 = {0.f, 0.f, 0.f, 0.f}, s1 = s0;
                if (ROT) { if ((wc & 1) == 0 && fq < 2) { const int pos = row < 32768 ? (row & 16383) : (row & 2047); const f32x4* tp = (const f32x4*)(rot + (size_t)pos * 16);
                        c0 = tp[0]; c1 = tp[1]; s0 = tp[2]; s1 = tp[3]; if (fq == 0) { s0 = -s0; s1 = -s1; } } }
#pragma unroll
                for (int bj = 0; bj < 2; ++bj) { f32x4 v0 = acc[ai][bj][m][0], v1 = acc[ai][bj][m][1];
                    if (ACT == 2) {
#pragma unroll
                        for (int e = 0; e < 4; ++e) { const float a0 = fmaxf(v0[e], 0.f), a1 = fmaxf(v1[e], 0.f); v0[e] = a0 * a0; v1[e] = a1 * a1; } }
                    if (ROT) { if ((wc & 1) == 0) { f32x4 p0, p1;
#pragma unroll
                            for (int e = 0; e < 4; ++e) { p0[e] = __shfl_xor(v0[e], 16); p1[e] = __shfl_xor(v1[e], 16); }
                            v0 = v0 * c0 + p0 * s0; v1 = v1 * c1 + p1 * s1; } }
                    u32x4 w; w.x = cvt_pk_bf16(v0[0], v0[1]); w.y = cvt_pk_bf16(v0[2], v0[3]); w.z = cvt_pk_bf16(v1[0], v1[1]); w.w = cvt_pk_bf16(v1[2], v1[3]);
                    *(u32x4*)(rowp + bj * HALF) = w; } }
    }
};
struct EpiGateRes {
    static constexpr bool PERM = false, AFTER_DRAIN = false;
    const float* xp; const float* xs; float* out; const float* gate; int row_off;
    __device__ __forceinline__ void operator()(const f32x4 (&acc)[2][2][4][2], const Unit& u, int wr, int wc, int fr, int fq) const {
        const int grow0 = row_off + u.pm * BM;
        const int mb = grow0 < 32768 ? (grow0 >> 14) : 2 + ((grow0 - 32768) >> 11);
        const int col0 = u.pn * BM + wc * 32 + 4 * fq;
        const float* gp = gate + (size_t)mb * 6144 + col0;
        f32x4 gv[2][2];
#pragma unroll
        for (int bj = 0; bj < 2; ++bj)
#pragma unroll
            for (int n = 0; n < 2; ++n) gv[bj][n] = *(const f32x4*)(gp + bj * HALF + n * 16);
#pragma unroll
        for (int ai = 0; ai < 2; ++ai)
#pragma unroll
            for (int m = 0; m < 4; ++m) { const int row = grow0 + ai * HALF + wr * 64 + m * 16 + fr;
                const float* bp = (xp ? (row < 32768 ? xp + (size_t)row * 1024 : xs + (size_t)(row - 32768) * 1024) : out + (size_t)row * 1024) + col0;
                float* op = out + (size_t)row * 1024 + col0;
#pragma unroll
                for (int bj = 0; bj < 2; ++bj)
#pragma unroll
                    for (int n = 0; n < 2; ++n) { const f32x4 b = *(const f32x4*)(bp + bj * HALF + n * 16); *(f32x4*)(op + bj * HALF + n * 16) = b + gv[bj][n] * acc[ai][bj][m][n]; }
                if (m & 1) asm volatile("" ::: "memory"); }
    }
};
template <class Epi, class Sched, bool ALIGN_EPI = false, bool SP2 = false>
__device__ __forceinline__ void gemm_phase(PG8_LAS unsigned char* lds, const Gemm g, const Sched& S, const Epi& E) {
    int tid_ = threadIdx.x; asm volatile("" : "+v"(tid_));
    const int tid = tid_, wid = __builtin_amdgcn_readfirstlane(tid >> 6), lane = tid & 63, wr = wid >> 2, wc = wid & 3, fr = lane & 15, fq = lane >> 4;
    const int K = g.K, nt = K / BK;
    unsigned voffA[2], voffB[2];
#pragma unroll
    for (int i = 0; i < 2; ++i) { int R, C; stage_rc(tid * 16 + i * 8192, R, C); const int Rb = Epi::PERM ? ((R & ~31) + perm32(R & 31)) : R;
        voffA[i] = (unsigned)(R * K + C) * 2u; voffB[i] = (unsigned)(Rb * K + C) * 2u; }
    const size_t kstep = (size_t)(BK * 2);
    const size_t hstep = (size_t)HALF * K * 2;
    const size_t tstep = 2 * hstep;
    const unsigned ldsw = (unsigned)wid * 1024u;
    const int aoff = lds_byte(wr * 64 + fr, fq * 8), boff = lds_byte(wc * 32 + fr, fq * 8);
#define PG8_SA(b, h) (((b) * 2 + (h)) * HTB)
#define PG8_SB(b, h) ((4 + (b) * 2 + (h)) * HTB)
#define PG8_STAGE(bufoff, gbase, voff) do { _Pragma("unroll") for (int _i = 0; _i < 2; ++_i) \
        __builtin_amdgcn_global_load_lds((const unsigned*)((const char*)(gbase) + (voff)[_i]), (PG8_LAS unsigned*)(lds + (bufoff) + ldsw + _i * 8192), 16, 0, 0); } while (0)
#define PG8_LDA(dst, b, h) do { _Pragma("unroll") for (int m = 0; m < 4; ++m) _Pragma("unroll") for (int k = 0; k < 2; ++k) dst[m][k] = *(const PG8_LAS bf16x8*)(lds + PG8_SA(b, h) + aoff + m * 2048 + k * 1024); } while (0)
#define PG8_LDB(dst, b, h) do { _Pragma("unroll") for (int n = 0; n < 2; ++n) _Pragma("unroll") for (int k = 0; k < 2; ++k) dst[n][k] = *(const PG8_LAS bf16x8*)(lds + PG8_SB(b, h) + boff + n * 2048 + k * 1024); } while (0)
#define PG8_MMA(ai, bj, At, Bt) do { __builtin_amdgcn_s_setprio(1); _Pragma("unroll") for (int m = 0; m < 4; ++m) _Pragma("unroll") for (int n = 0; n < 2; ++n) _Pragma("unroll") for (int k = 0; k < 2; ++k) \
        acc[ai][bj][m][n] = __builtin_amdgcn_mfma_f32_16x16x32_bf16(Bt[n][k], At[m][k], acc[ai][bj][m][n], 0, 0, 0); __builtin_amdgcn_s_setprio(0); } while (0)
#define PG8_WAIT_V(n) asm volatile("s_waitcnt vmcnt(" #n ")" ::: "memory")
#define PG8_WAIT_L(n) asm volatile("s_waitcnt lgkmcnt(" #n ")" ::: "memory")
#define PG8_BAR __builtin_amdgcn_s_barrier()
#define PG8_SCHED __builtin_amdgcn_sched_barrier(0)
    Unit cur, nxt; int ui = 0;
    if (!S.next(0, cur)) return;
    f32x4 acc[2][2][4][2];
#pragma unroll
    for (int a = 0; a < 2; ++a)
#pragma unroll
        for (int b = 0; b < 2; ++b)
#pragma unroll
            for (int m = 0; m < 4; ++m)
#pragma unroll
                for (int n = 0; n < 2; ++n) acc[a][b][m][n] = (f32x4){0.f, 0.f, 0.f, 0.f};
    bf16x8 At[4][2], B0[2][2], B1[2][2];
    const char* cA = (const char*)g.A + (size_t)cur.pm * tstep; const char* cB = (const char*)g.Bt + (size_t)cur.pn * tstep;
    S.a_ready(cur);
    if constexpr (SP2) {
        PG8_STAGE(PG8_SB(0, 0), cB, voffB); PG8_STAGE(PG8_SB(0, 1), cB + hstep, voffB); PG8_STAGE(PG8_SA(0, 0), cA, voffA); PG8_STAGE(PG8_SA(0, 1), cA + hstep, voffA);
        if (wr == 1) PG8_BAR;
        PG8_WAIT_V(2); PG8_BAR;
        PG8_STAGE(PG8_SB(1, 0), cB + kstep, voffB); PG8_STAGE(PG8_SA(1, 0), cA + kstep, voffA); PG8_STAGE(PG8_SB(1, 1), cB + hstep + kstep, voffB);
        PG8_WAIT_V(6); PG8_BAR;
    } else {
        PG8_STAGE(PG8_SB(0, 0), cB, voffB); PG8_STAGE(PG8_SA(0, 0), cA, voffA); PG8_STAGE(PG8_SB(0, 1), cB + hstep, voffB); PG8_STAGE(PG8_SA(0, 1), cA + hstep, voffA);
        if (wr == 1) PG8_BAR;
        PG8_WAIT_V(4); PG8_BAR;
        PG8_STAGE(PG8_SB(1, 0), cB + kstep, voffB); PG8_STAGE(PG8_SA(1, 0), cA + kstep, voffA); PG8_STAGE(PG8_SB(1, 1), cB + hstep + kstep, voffB);
        PG8_WAIT_V(6); PG8_BAR;
    }
    for (;;) {
        const bool has_next = S.next(ui + 1, nxt);
        const char* nA = has_next ? (const char*)g.A + (size_t)nxt.pm * tstep : cA; const char* nB = has_next ? (const char*)g.Bt + (size_t)nxt.pn * tstep : cB;
        for (int t = 0; t < nt; t += 2) {
            const bool last = (t == nt - 2);
            const char* a1 = cA + (size_t)(t + 1) * kstep;
            const char* a2 = last ? nA : cA + (size_t)(t + 2) * kstep; const char* b2 = last ? nB : cB + (size_t)(t + 2) * kstep;
            const char* a3 = a2 + kstep; const char* b3 = b2 + kstep;
            if (last && has_next) S.a_ready(nxt);
            if constexpr (SP2) {
            PG8_LDB(B0, 0, 0); PG8_LDB(B1, 0, 1); PG8_SCHED; PG8_LDA(At, 0, 0); PG8_STAGE(PG8_SA(1, 1), a1 + hstep, voffA);
            PG8_WAIT_V(8); PG8_WAIT_L(0); PG8_BAR; PG8_MMA(0, 0, At, B0); PG8_MMA(0, 1, At, B1); PG8_BAR; PG8_SCHED;
            PG8_LDA(At, 0, 1); PG8_STAGE(PG8_SB(0, 0), b2, voffB); PG8_STAGE(PG8_SB(0, 1), b2 + hstep, voffB); PG8_STAGE(PG8_SA(0, 0), a2, voffA);
            PG8_WAIT_V(8); PG8_WAIT_L(0); PG8_BAR; PG8_MMA(1, 0, At, B0); PG8_MMA(1, 1, At, B1); PG8_BAR; PG8_SCHED;
            PG8_LDB(B0, 1, 0); PG8_LDB(B1, 1, 1); PG8_SCHED; PG8_LDA(At, 1, 0); PG8_STAGE(PG8_SA(0, 1), a2 + hstep, voffA);
            PG8_WAIT_V(8); PG8_WAIT_L(0); PG8_BAR; PG8_MMA(0, 0, At, B0); PG8_MMA(0, 1, At, B1); PG8_BAR; PG8_SCHED;
            PG8_LDA(At, 1, 1); PG8_STAGE(PG8_SB(1, 0), b3, voffB); PG8_STAGE(PG8_SB(1, 1), b3 + hstep, voffB); PG8_STAGE(PG8_SA(1, 0), a3, voffA);
            PG8_WAIT_V(8); PG8_WAIT_L(0); PG8_BAR; PG8_MMA(1, 0, At, B0); PG8_MMA(1, 1, At, B1); PG8_BAR; PG8_SCHED;
            } else {
            PG8_LDB(B0, 0, 0); PG8_SCHED; PG8_LDA(At, 0, 0); PG8_STAGE(PG8_SA(1, 1), a1 + hstep, voffA);
            PG8_WAIT_L(8); PG8_BAR; PG8_WAIT_L(0); PG8_MMA(0, 0, At, B0); PG8_BAR; PG8_SCHED;
            PG8_LDB(B1, 0, 1); PG8_STAGE(PG8_SB(0, 0), b2, voffB);
            PG8_BAR; PG8_WAIT_L(0); PG8_MMA(0, 1, At, B1); PG8_BAR;
            PG8_LDA(At, 0, 1); PG8_STAGE(PG8_SA(0, 0), a2, voffA);
            PG8_BAR; PG8_WAIT_L(0); PG8_MMA(1, 0, At, B0); PG8_BAR; PG8_SCHED;
            PG8_STAGE(PG8_SB(0, 1), b2 + hstep, voffB);
            PG8_WAIT_V(6); PG8_BAR; PG8_MMA(1, 1, At, B1); PG8_BAR;
            PG8_LDB(B0, 1, 0); PG8_SCHED; PG8_LDA(At, 1, 0); PG8_STAGE(PG8_SA(0, 1), a2 + hstep, voffA);
            PG8_WAIT_L(8); PG8_BAR; PG8_WAIT_L(0); PG8_MMA(0, 0, At, B0); PG8_BAR; PG8_SCHED;
            PG8_LDB(B1, 1, 1); PG8_STAGE(PG8_SB(1, 0), b3, voffB);
            PG8_BAR; PG8_WAIT_L(0); PG8_MMA(0, 1, At, B1); PG8_BAR;
            PG8_LDA(At, 1, 1); PG8_STAGE(PG8_SA(1, 0), a3, voffA);
            PG8_BAR; PG8_WAIT_L(0); PG8_MMA(1, 0, At, B0); PG8_BAR; PG8_SCHED;
            PG8_STAGE(PG8_SB(1, 1), b3 + hstep, voffB);
            PG8_WAIT_V(6); PG8_BAR; PG8_MMA(1, 1, At, B1); PG8_BAR;
            }
        }
        if constexpr (ALIGN_EPI) { if (wr == 0) PG8_BAR; }
        if constexpr (!Epi::AFTER_DRAIN) { E(acc, cur, wr, wc, fr, fq); S.done(cur); }
        if (!has_next) break;
#pragma unroll
        for (int a = 0; a < 2; ++a)
#pragma unroll
            for (int b = 0; b < 2; ++b)
#pragma unroll
                for (int m = 0; m < 4; ++m)
#pragma unroll
                    for (int n = 0; n < 2; ++n) acc[a][b][m][n] = (f32x4){0.f, 0.f, 0.f, 0.f};
        cur = nxt; cA = nA; cB = nB; ++ui;
        if constexpr (ALIGN_EPI) { if (wr == 1) PG8_BAR; }
    }
    PG8_WAIT_V(0);
    if constexpr (!ALIGN_EPI) { if (wr == 0) PG8_BAR; }
    PG8_BAR;
    if constexpr (Epi::AFTER_DRAIN) { E.fused(acc, cur, wr, wc, fr, fq, lds, wid, lane); S.done(cur); }
#undef PG8_SA
#undef PG8_SB
#undef PG8_STAGE
#undef PG8_LDA
#undef PG8_LDB
#undef PG8_MMA
#undef PG8_WAIT_V
#undef PG8_WAIT_L
#undef PG8_BAR
#undef PG8_SCHED
}
}
#ifndef PG8_SP2
#define PG8_SP2 true
#endif
#ifndef PG8_ALIGN
#define PG8_ALIGN true
#endif
constexpr int D = 1024, T_P = 32768, T_S = 65536, TT = T_P + T_S, L_P = 16384, L_S = 2048, NB_ROWS = 34, DIN = 3072, FF = 4096, HW = 512;
constexpr size_t MiB = 1u << 20;
constexpr size_t WS_WIN = 2 * MiB, WS_WOUT = 8 * MiB, WS_W1 = 10 * MiB, WS_W2 = 18 * MiB, WS_MOD = 26 * MiB, WS_ROT = 27 * MiB, WS_KRP = 28 * MiB, WS_KRS = 60 * MiB,
                 WS_XN = 64 * MiB, WS_UT = 256 * MiB, WS_QK = 544 * MiB, WS_VT = 736 * MiB, WS_YT = 832 * MiB, WS_END = 928 * MiB, WS_H = WS_UT;
constexpr int MLP_CHUNK = 49152, N_CHUNK = TT / MLP_CHUNK;
constexpr int LDS_BYTES = 147456;
constexpr int PH_P0 = 0, PH_XN1 = 1, PH_INPROJ = 2, PH_MIX = 3, PH_HNORM = 4, PH_OUTPROJ = 5, PH_XN2 = 6, PH_MLP0 = 7, PH_FINAL = PH_MLP0 + 2 * N_CHUNK, N_PHASES = PH_FINAL + 1;

#define GAS __attribute__((address_space(1)))
#define LAS __attribute__((address_space(3)))
typedef unsigned short bf16;
typedef unsigned v4u __attribute__((ext_vector_type(4)));
typedef unsigned u32x2 __attribute__((ext_vector_type(2)));
typedef float f32x4 __attribute__((ext_vector_type(4)));
typedef float f32x16 __attribute__((ext_vector_type(16)));
typedef short bf16x8 __attribute__((ext_vector_type(8)));
typedef short s16x4 __attribute__((ext_vector_type(4)));
typedef LAS unsigned char* ldsp;
#define LDS_WAIT() asm volatile("s_waitcnt lgkmcnt(0)" ::: "memory")
__device__ __forceinline__ unsigned f2bf(float f) { unsigned u = __builtin_bit_cast(unsigned, f); return (u + 0x7fffu + ((u >> 16) & 1u)) >> 16; }
__device__ __forceinline__ unsigned pk2(float lo, float hi) { return f2bf(lo) | (f2bf(hi) << 16); }
__device__ __forceinline__ float bflo(unsigned w) { return __builtin_bit_cast(float, w << 16); }
__device__ __forceinline__ float bfhi(unsigned w) { return __builtin_bit_cast(float, w & 0xffff0000u); }
__device__ __forceinline__ float bf2f(unsigned short b) { return __builtin_bit_cast(float, ((unsigned)b) << 16); }
__device__ __forceinline__ float wave_sum(float v) {
#pragma unroll
    for (int o = 1; o < 64; o <<= 1) v += __shfl_xor(v, o);
    return v;
}
__device__ __forceinline__ float rdlane(float v, int i) { return __builtin_bit_cast(float, __builtin_amdgcn_readlane(__builtin_bit_cast(int, v), i)); }
__device__ __forceinline__ int batch_of_row(int row) { return row < T_P ? (row >> 14) : 2 + ((row - T_P) >> 11); }

struct Args { const float* in[30]; float* out; unsigned char* ws; int ph_lo, ph_hi; };

__device__ __forceinline__ void p0_transpose_item(const float* W, int K, int N, bf16* WT, int row_off, LAS float* scr, int item, int lane) {
    const int nblk = N / 32, kb = item / nblk, nb = item % nblk, k0 = 64 * kb, n0 = 32 * nb;
    float tv[32];
#pragma unroll
    for (int i = 0; i < 32; ++i) tv[i] = W[(size_t)(k0 + 2 * i + (lane >> 5)) * N + n0 + (lane & 31)];
#pragma unroll
    for (int i = 0; i < 32; ++i) scr[(2 * i + (lane >> 5)) * 33 + (lane & 31)] = tv[i];
    LDS_WAIT(); asm volatile("" ::: "memory");
    const int c = lane & 7;
#pragma unroll
    for (int j = 0; j < 4; ++j) { const int n = (lane >> 3) + 8 * j; const LAS float* s = scr + (8 * c) * 33 + n;
        v4u o; o.x = pk2(s[0 * 33], s[1 * 33]); o.y = pk2(s[2 * 33], s[3 * 33]); o.z = pk2(s[4 * 33], s[5 * 33]); o.w = pk2(s[6 * 33], s[7 * 33]);
        *(GAS v4u*)(WT + (size_t)(row_off + n0 + n) * K + k0 + 8 * c) = o; }
    LDS_WAIT(); asm volatile("" ::: "memory");
}
__device__ __forceinline__ void adaln_item(ldsp lds, const Args& a, float* MOD, int item, int tid, int wid, int lane) {
    LAS float* sc = (LAS float*)lds;
    const float* cp = a.in[2]; const float* cs = a.in[3];
    for (int idx = tid; idx < NB_ROWS * D; idx += 512) { const int r = idx >> 10, k = idx & 1023; const float x = r < 2 ? cp[r * D + k] : cs[(r - 2) * D + k]; sc[idx] = x / (1.f + expf(-x)); }
    __syncthreads();
    const int n0 = item * 64; const float* W = a.in[4] + n0 + lane;
    float acc[NB_ROWS];
#pragma unroll
    for (int r = 0; r < NB_ROWS; ++r) acc[r] = 0.f;
    for (int k = wid * 128; k < wid * 128 + 128; k += 4) {
        const float w0 = W[(size_t)k * 6144], w1 = W[(size_t)(k + 1) * 6144], w2 = W[(size_t)(k + 2) * 6144], w3 = W[(size_t)(k + 3) * 6144];
#pragma unroll
        for (int r = 0; r < NB_ROWS; ++r) { const f32x4 s = *(const LAS f32x4*)(sc + r * D + k); acc[r] += (s.x * w0 + s.y * w1) + (s.z * w2 + s.w * w3); }
    }
    __syncthreads();
    LAS float* part = (LAS float*)lds;
#pragma unroll
    for (int r = 0; r < NB_ROWS; ++r) part[(wid * NB_ROWS + r) * 64 + lane] = acc[r];
    __syncthreads();
    for (int r = wid; r < NB_ROWS; r += 8) { float s = a.in[5][n0 + lane];
#pragma unroll
        for (int p = 0; p < 8; ++p) s += part[(p * NB_ROWS + r) * 64 + lane];
        MOD[(size_t)r * 6144 + n0 + lane] = s; }
    __syncthreads();
}

__device__ __forceinline__ int crow16(int r, int hi) { return (r & 3) + 8 * (r >> 2) + 4 * hi; }
__device__ __forceinline__ void filter_item32(const Args& a, int L, bf16* KR, int t0, int np0, int npn, int lane) {
    const float *w1 = a.in[10], *b1 = a.in[11], *w2 = a.in[12], *b2 = a.in[13], *w3 = a.in[14], *b3 = a.in[15], *w4 = a.in[16], *fq = a.in[17];
    const int n = lane & 31, hi = lane >> 5, t = t0 + n;
    const float tt = (float)t * (1.0f / (float)(L - 1)), w = 6.283185307179586f * (float)t / (float)L;
    f32x16 h0 = {}, h1 = {};
    {
        float cv[8], sv[8];
#pragma unroll
        for (int k = 0; k < 8; ++k) { const float f = 1e-4f + (float)(k + 8 * hi) * ((15.0f - 1e-4f) / 15.0f); float s, c; sincosf(f * w, &s, &c); cv[k] = c; sv[k] = -s; }
#pragma unroll
        for (int kk = 0; kk < 17; ++kk) {
            const int urow = kk < 8 ? 1 + kk : (kk < 16 ? 17 + (kk - 8) : 0);
            const float zb = kk < 8 ? cv[kk & 7] : (kk < 16 ? sv[kk & 7] : (hi == 0 ? tt : 0.f));
            const float* ub = w1 + urow * 64; const int lo1 = kk < 16 ? 8 * hi * 64 + n : n;
            const float a0 = ub[lo1], a1 = ub[lo1 + 32];
            h0 = __builtin_amdgcn_mfma_f32_32x32x2f32(a0, zb, h0, 0, 0, 0); h1 = __builtin_amdgcn_mfma_f32_32x32x2f32(a1, zb, h1, 0, 0, 0);
        }
#pragma unroll
        for (int r = 0; r < 16; ++r) { const int j = crow16(r, hi); h0[r] = sinf(fq[j] * (h0[r] + b1[j])); h1[r] = sinf(fq[32 + j] * (h1[r] + b1[32 + j])); }
    }
#pragma unroll
    for (int layer = 0; layer < 2; ++layer) {
        const float* W = layer ? w3 : w2; const float* bb = layer ? b3 : b2;
        f32x16 g0 = {}, g1 = {}; const int lo2 = 4 * hi * 64 + n;
#pragma unroll
        for (int kk = 0; kk < 32; ++kk) {
            const float* ub = W + (32 * (kk >> 4) + crow16(kk & 15, 0)) * 64;
            const float zb = kk < 16 ? h0[kk & 15] : h1[kk & 15];
            const float a0 = ub[lo2], a1 = ub[lo2 + 32];
            g0 = __builtin_amdgcn_mfma_f32_32x32x2f32(a0, zb, g0, 0, 0, 0); g1 = __builtin_amdgcn_mfma_f32_32x32x2f32(a1, zb, g1, 0, 0, 0);
        }
#pragma unroll
        for (int r = 0; r < 16; ++r) { const int j = crow16(r, hi); h0[r] = sinf(fq[j] * (g0[r] + bb[j])); h1[r] = sinf(fq[32 + j] * (g1[r] + bb[32 + j])); }
    }
    const float dmin = -3.0701134573253943f, dmax = -15.350567286626972f;
#pragma unroll 1
    for (int np = np0; np < np0 + npn; ++np) {
        f32x16 of = {}, ob = {};
        const float* wr = w4 + 32 * np; const int lo4 = 4 * hi * 1024 + n;
#pragma unroll
        for (int kk = 0; kk < 32; ++kk) {
            const float* ub = wr + (32 * (kk >> 4) + crow16(kk & 15, 0)) * 1024;
            const float zb = kk < 16 ? h0[kk & 15] : h1[kk & 15];
            const float af = ub[lo4], ab = ub[lo4 + 512];
            of = __builtin_amdgcn_mfma_f32_32x32x2f32(af, zb, of, 0, 0, 0); ob = __builtin_amdgcn_mfma_f32_32x32x2f32(ab, zb, ob, 0, 0, 0);
        }
#pragma unroll
        for (int r = 0; r < 16; ++r) { const int c = 32 * np + crow16(r, hi); const float ad = -(dmin + (float)c * ((dmax - dmin) / 511.0f));
            const float dec = expf(-tt * ad); bf16* kr = KR + (size_t)c * (2 * L);
            if (t == 0) { kr[L] = (bf16)f2bf(of[r] + ob[r]); kr[0] = 0; } else { kr[L - t] = (bf16)f2bf(of[r] * dec); kr[L + t] = (bf16)f2bf(ob[r] * dec); } }
    }
}

template <int MODE> __device__ __forceinline__ void norm_row(const float* xrow, const float* nw, const float* sc, const float* sh, bf16* orow, float* frow, float eps, int lane) {
    const f32x4* xr = (const f32x4*)xrow + lane;
    f32x4 v[4]; float s = 0.f;
#pragma unroll
    for (int j = 0; j < 4; ++j) { v[j] = xr[64 * j]; s += (v[j].x * v[j].x + v[j].y * v[j].y) + (v[j].z * v[j].z + v[j].w * v[j].w); }
    const float r = 1.f / sqrtf(wave_sum(s) * (1.f / D) + eps);
#pragma unroll
    for (int j = 0; j < 4; ++j) { const f32x4 w = ((const f32x4*)nw)[64 * j + lane]; f32x4 y = v[j] * r * w;
        if (MODE == 0) { const f32x4 c = ((const f32x4*)sc)[64 * j + lane], h = ((const f32x4*)sh)[64 * j + lane]; y = y * (c + 1.f) + h;
            u32x2 o; o.x = pk2(y.x, y.y); o.y = pk2(y.z, y.w); ((u32x2*)orow)[64 * j + lane] = o; }
        else ((f32x4*)frow)[64 * j + lane] = y; }
}
template <int MODE> __device__ __forceinline__ void norm_row2(const float* xa, const float* xb, const float* nw, const float* sca, const float* sha, const float* scb, const float* shb,
                                                              bf16* oa, bf16* ob, float* fa_, float* fb_, float eps, int lane) {
    const f32x4* pa = (const f32x4*)xa + lane; const f32x4* pb = (const f32x4*)xb + lane;
    f32x4 va[4], vb[4]; float s0 = 0.f, s1 = 0.f;
#pragma unroll
    for (int j = 0; j < 4; ++j) { va[j] = pa[64 * j]; vb[j] = pb[64 * j]; }
#pragma unroll
    for (int j = 0; j < 4; ++j) { s0 += (va[j].x * va[j].x + va[j].y * va[j].y) + (va[j].z * va[j].z + va[j].w * va[j].w); s1 += (vb[j].x * vb[j].x + vb[j].y * vb[j].y) + (vb[j].z * vb[j].z + vb[j].w * vb[j].w); }
#pragma unroll
    for (int o = 1; o < 64; o <<= 1) { s0 += __shfl_xor(s0, o); s1 += __shfl_xor(s1, o); }
    const float r0 = 1.f / sqrtf(s0 * (1.f / D) + eps), r1 = 1.f / sqrtf(s1 * (1.f / D) + eps);
#pragma unroll
    for (int j = 0; j < 4; ++j) { const f32x4 w = ((const f32x4*)nw)[64 * j + lane]; f32x4 ya = va[j] * r0 * w, yb = vb[j] * r1 * w;
        if (MODE == 0) { const f32x4 ca = ((const f32x4*)sca)[64 * j + lane], ha = ((const f32x4*)sha)[64 * j + lane], cb = ((const f32x4*)scb)[64 * j + lane], hb = ((const f32x4*)shb)[64 * j + lane];
            ya = ya * (ca + 1.f) + ha; yb = yb * (cb + 1.f) + hb;
            u32x2 o; o.x = pk2(ya.x, ya.y); o.y = pk2(ya.z, ya.w); ((u32x2*)oa)[64 * j + lane] = o; o.x = pk2(yb.x, yb.y); o.y = pk2(yb.z, yb.w); ((u32x2*)ob)[64 * j + lane] = o; }
        else { ((f32x4*)fa_)[64 * j + lane] = ya; ((f32x4*)fb_)[64 * j + lane] = yb; } }
}
__device__ __forceinline__ void hyena_unit(ldsp lds, const Args& a, const bf16* UT, const bf16* KRP, const bf16* KRS, bf16* YT, int unit, int tid, int wid, int lane) {
    const bool pr = unit < HW;
    const int c = pr ? unit : ((unit - HW) >> 1), half = pr ? 0 : ((unit - HW) & 1);
    const int L = pr ? L_P : L_S, Nb = L >> 5, nseq = pr ? 2 : 16;
    const int SP = (Nb + 64) * 64;
    const int HY_SOFF = 4 * L + 64;
    const bf16* KR = (pr ? KRP : KRS) + (size_t)c * (2 * L);
    { const int nz = (nseq * SP) >> 4; for (int i = tid; i < nz; i += 512) *(LAS v4u*)(lds + HY_SOFF + i * 16) = (v4u){0u, 0u, 0u, 0u};
      if (tid < 4) *(LAS v4u*)(lds + 4 * L + tid * 16) = (v4u){0u, 0u, 0u, 0u}; }
    { const int nc = (4 * L) >> 4; for (int i = tid; i < nc; i += 512) *(LAS v4u*)(lds + i * 16) = *(const v4u*)((const char*)KR + (size_t)i * 16); }
    __syncthreads();
    const float* cw = a.in[8]; const float* cb = a.in[9];
    {
        const float a0 = cw[HW + c], a1 = cw[1536 + HW + c], a2 = cw[3072 + HW + c], ab = cb[HW + c];
        const float v0 = cw[2 * HW + c], v1 = cw[1536 + 2 * HW + c], v2 = cw[3072 + 2 * HW + c], vb = cb[2 * HW + c];
        const int gps = L >> 3, total = nseq * gps;
        (void)total;
#pragma unroll
        for (int bt = 0; bt < 2; ++bt) {
            v4u r1[4], r2[4]; unsigned short h1m[4], h1p[4], h2m[4], h2p[4]; int tq[4], sq_[4];
#pragma unroll
            for (int q = 0; q < 4; ++q) {
                const int g = tid + 512 * (4 * bt + q); const int seq = g / gps, tg = g - seq * gps, t = tg << 3; tq[q] = t; sq_[q] = seq;
                const size_t tok = (size_t)(pr ? seq * L_P : T_P + (half * 16 + seq) * L_S) + t;
                const bf16* p1 = UT + (size_t)(HW + c) * TT + tok; const bf16* p2 = UT + (size_t)(2 * HW + c) * TT + tok;
                r1[q] = *(const v4u*)p1; r2[q] = *(const v4u*)p2;
                const int im = t > 0 ? -1 : 0, ip = t + 8 < L ? 8 : 7;
                h1m[q] = p1[im]; h2m[q] = p2[im]; h1p[q] = p1[ip]; h2p[q] = p2[ip];
            }
#pragma unroll
            for (int q = 0; q < 4; ++q) {
                const int t = tq[q], seq = sq_[q]; const v4u ra = r1[q], rb2 = r2[q];
                float x[10], y[10];
                x[0] = t > 0 ? bf2f(h1m[q]) : 0.f; y[0] = t > 0 ? bf2f(h2m[q]) : 0.f;
                x[9] = t + 8 < L ? bf2f(h1p[q]) : 0.f; y[9] = t + 8 < L ? bf2f(h2p[q]) : 0.f;
                x[1] = bflo(ra.x); x[2] = bfhi(ra.x); x[3] = bflo(ra.y); x[4] = bfhi(ra.y); x[5] = bflo(ra.z); x[6] = bfhi(ra.z); x[7] = bflo(ra.w); x[8] = bfhi(ra.w);
                y[1] = bflo(rb2.x); y[2] = bfhi(rb2.x); y[3] = bflo(rb2.y); y[4] = bfhi(rb2.y); y[5] = bflo(rb2.z); y[6] = bfhi(rb2.z); y[7] = bflo(rb2.w); y[8] = bfhi(rb2.w);
                float sv[8];
#pragma unroll
                for (int e = 0; e < 8; ++e) sv[e] = (a0 * x[e] + a1 * x[e + 1] + a2 * x[e + 2] + ab) * (v0 * y[e] + v1 * y[e + 1] + v2 * y[e + 2] + vb);
                v4u o; o.x = pk2(sv[0], sv[1]); o.y = pk2(sv[2], sv[3]); o.z = pk2(sv[4], sv[5]); o.w = pk2(sv[6], sv[7]);
                const int r = 32 + (t >> 5), ci = (t & 31) >> 3;
                *(LAS v4u*)(lds + HY_SOFF + seq * SP + r * 64 + ((ci ^ ((r >> 2) & 3)) << 4)) = o;
            }
        }
    }
    __syncthreads();
    const int n = lane & 31, hi = lane >> 5;
    const int i0 = pr ? 64 * wid : 0, sq0 = pr ? 0 : 2 * wid, sq1 = sq0 + 1;
    const unsigned sb0 = HY_SOFF + sq0 * SP, sb1 = HY_SOFF + sq1 * SP;
    f32x16 acc00 = {}, acc01 = {}, acc10 = {}, acc11 = {};
    unsigned Xd[2][5], Yd[2][5]; v4u Xb0[2][2], Xb1[2][2], Yb0[2][2], Yb1[2][2];
    const unsigned hy_sh = (unsigned)(n & 1) << 4, hy_ab = (unsigned)(((L - n + 8 * hi) >> 1) * 4); const int hy_rb = 32 + i0 + n;
#define HY_LOAD(dd, T0, T1, P) do { const int dq_ = (dd); \
        const LAS unsigned* fp = (const LAS unsigned*)(lds + (hy_ab - 64u * (unsigned)dq_)); \
        _Pragma("unroll") for (int kk = 0; kk < 2; ++kk) { P##d[kk][0] = fp[8 * kk]; P##d[kk][1] = fp[8 * kk + 1]; P##d[kk][2] = fp[8 * kk + 2]; P##d[kk][3] = fp[8 * kk + 3]; P##d[kk][4] = fp[8 * kk + 4]; } \
        const int r0_ = hy_rb - dq_; const unsigned off0_ = ((unsigned)r0_ << 6) + ((((unsigned)r0_ >> 2) & 3u) ^ (unsigned)hi) * 16u, off1_ = off0_ ^ 32u; \
        if (T0) { P##b0[0][0] = *(const LAS v4u*)(lds + sb0 + off0_); P##b0[0][1] = *(const LAS v4u*)(lds + sb1 + off0_); P##b0[1][0] = *(const LAS v4u*)(lds + sb0 + off1_); P##b0[1][1] = *(const LAS v4u*)(lds + sb1 + off1_); } \
        if (T1) { P##b1[0][0] = *(const LAS v4u*)(lds + sb0 + off0_ + 2048); P##b1[0][1] = *(const LAS v4u*)(lds + sb1 + off0_ + 2048); P##b1[1][0] = *(const LAS v4u*)(lds + sb0 + off1_ + 2048); P##b1[1][1] = *(const LAS v4u*)(lds + sb1 + off1_ + 2048); } } while (0)
#define HY_COMP(T0, T1, P) do { _Pragma("unroll") for (int kk = 0; kk < 2; ++kk) { const unsigned sh = hy_sh; v4u aw; \
        aw.x = __builtin_amdgcn_alignbit(P##d[kk][1], P##d[kk][0], sh); aw.y = __builtin_amdgcn_alignbit(P##d[kk][2], P##d[kk][1], sh); \
        aw.z = __builtin_amdgcn_alignbit(P##d[kk][3], P##d[kk][2], sh); aw.w = __builtin_amdgcn_alignbit(P##d[kk][4], P##d[kk][3], sh); \
        const bf16x8 A = __builtin_bit_cast(bf16x8, aw); \
        if (T0) { acc00 = __builtin_amdgcn_mfma_f32_32x32x16_bf16(A, __builtin_bit_cast(bf16x8, P##b0[kk][0]), acc00, 0, 0, 0); \
                  acc01 = __builtin_amdgcn_mfma_f32_32x32x16_bf16(A, __builtin_bit_cast(bf16x8, P##b0[kk][1]), acc01, 0, 0, 0); } \
        if (T1) { acc10 = __builtin_amdgcn_mfma_f32_32x32x16_bf16(A, __builtin_bit_cast(bf16x8, P##b1[kk][0]), acc10, 0, 0, 0); \
                  acc11 = __builtin_amdgcn_mfma_f32_32x32x16_bf16(A, __builtin_bit_cast(bf16x8, P##b1[kk][1]), acc11, 0, 0, 0); } } } while (0)
#define HY_SB() __builtin_amdgcn_sched_barrier(0)
#define HY_SEG(dlo, dhi, T0, T1) do { int d = (dlo); const int dh_ = (dhi); HY_LOAD(d, T0, T1, X); HY_SB(); \
        for (; d + 1 <= dh_; d += 2) { HY_LOAD(d + 1, T0, T1, Y); HY_SB(); HY_COMP(T0, T1, X); HY_SB(); \
            HY_LOAD((d + 2 <= dh_ ? d + 2 : dh_), T0, T1, X); HY_SB(); HY_COMP(T0, T1, Y); HY_SB(); } \
        if (d == dh_) { HY_COMP(T0, T1, X); HY_SB(); } } while (0)
    HY_SEG(i0 - Nb + 1, i0 + 32 - Nb, true, false);
    HY_SEG(i0 + 33 - Nb, i0 + 31, true, true);
    HY_SEG(i0 + 32, i0 + 63, false, true);
#undef HY_LOAD
#undef HY_COMP
#undef HY_SB
#undef HY_SEG
    {
        const float a0 = cw[c], a1 = cw[1536 + c], a2 = cw[3072 + c], ab = cb[c], hb = a.in[18][c];
#pragma unroll
        for (int ts = 0; ts < 4; ++ts) {
            const int tile = ts >> 1, sl = ts & 1; const f32x16 acc = ts == 0 ? acc00 : (ts == 1 ? acc01 : (ts == 2 ? acc10 : acc11));
            const int sq = sl ? sq1 : sq0; const int i = i0 + 32 * tile + n;
            const size_t tokb = (size_t)(pr ? sq * L_P : T_P + (half * 16 + sq) * L_S);
            const bf16* u0 = UT + (size_t)c * TT + tokb; bf16* yo = YT + (size_t)c * TT + tokb;
#pragma unroll
            for (int g4 = 0; g4 < 4; ++g4) {
                const int aa = 8 * g4 + 4 * hi, t = 32 * i + aa;
                const u32x2 ru = *(const u32x2*)(u0 + t);
                float x[6]; x[0] = t > 0 ? bf2f(u0[t - 1]) : 0.f; x[5] = t + 4 < L ? bf2f(u0[t + 4]) : 0.f;
                x[1] = bflo(ru.x); x[2] = bfhi(ru.x); x[3] = bflo(ru.y); x[4] = bfhi(ru.y);
                const int r = 32 + i, ci = aa >> 3;
                const u32x2 rs = *(const LAS u32x2*)(lds + HY_SOFF + sq * SP + r * 64 + ((ci ^ ((r >> 2) & 3)) << 4) + (aa & 7) * 2);
                const float s0 = bflo(rs.x), s1 = bfhi(rs.x), s2 = bflo(rs.y), s3 = bfhi(rs.y);
                const float y0 = (a0 * x[0] + a1 * x[1] + a2 * x[2] + ab) * (acc[4 * g4 + 0] + s0 * hb);
                const float y1 = (a0 * x[1] + a1 * x[2] + a2 * x[3] + ab) * (acc[4 * g4 + 1] + s1 * hb);
                const float y2 = (a0 * x[2] + a1 * x[3] + a2 * x[4] + ab) * (acc[4 * g4 + 2] + s2 * hb);
                const float y3 = (a0 * x[3] + a1 * x[4] + a2 * x[5] + ab) * (acc[4 * g4 + 3] + s3 * hb);
                u32x2 o; o.x = pk2(y0, y1); o.y = pk2(y2, y3); *(u32x2*)(yo + t) = o;
            }
        }
    }
    __syncthreads();
}

__device__ __forceinline__ void hnorm_phase(ldsp lds, const Args& a, const bf16* YT, bf16* MIX, int bx, int G, int tid, int wid, int lane) {
    LAS unsigned* tile = (LAS unsigned*)lds;
    const float* hw = a.in[19];
    constexpr int NIT = TT / 64;
    v4u pre[8];
    int it = bx;
    if (it < NIT) {
#pragma unroll
        for (int q = 0; q < 8; ++q) { const int idx = tid + 512 * q, c = idx >> 3, k = idx & 7; pre[q] = *(const v4u*)(YT + (size_t)c * TT + it * 64 + 8 * k); } }
    for (; it < NIT; it += G) {
        const int tok0 = it * 64;
#pragma unroll
        for (int q = 0; q < 8; ++q) { const int idx = tid + 512 * q, c = idx >> 3, k = idx & 7; LAS unsigned* p = tile + c * 33 + 4 * k; p[0] = pre[q].x; p[1] = pre[q].y; p[2] = pre[q].z; p[3] = pre[q].w; }
        __syncthreads();
        if (it + G < NIT) {
#pragma unroll
            for (int q = 0; q < 8; ++q) { const int idx = tid + 512 * q, c = idx >> 3, k = idx & 7; pre[q] = *(const v4u*)(YT + (size_t)c * TT + (it + G) * 64 + 8 * k); } }
        for (int tt = wid * 8; tt < wid * 8 + 8; ++tt) {
            float v[8]; float ss = 0.f;
#pragma unroll
            for (int e = 0; e < 8; ++e) { const unsigned w = tile[(e * 64 + lane) * 33 + (tt >> 1)]; v[e] = (tt & 1) ? bfhi(w) : bflo(w); ss += v[e] * v[e]; }
            const float r = 1.f / sqrtf(wave_sum(ss) * (1.f / HW) + 1e-6f);
            bf16* orow = MIX + (size_t)(tok0 + tt) * D;
#pragma unroll
            for (int e = 0; e < 8; ++e) orow[e * 64 + lane] = (bf16)f2bf(v[e] * r * hw[e * 64 + lane]);
        }
        __syncthreads();
    }
}

constexpr int AT_KP = 272, AT_VP = 144, AT_KB = 64 * AT_KP, AT_VB = 128 * AT_VP, AT_V0 = 2 * AT_KB, AT_EX = 2 * AT_KB + 2 * AT_VB, AT_EXP = 132;
typedef float f32x2 __attribute__((ext_vector_type(2)));
typedef __bf16 at_bf16x2 __attribute__((ext_vector_type(2)));
__device__ __forceinline__ unsigned at_cvtpk(f32x2 v) { return __builtin_bit_cast(unsigned, __builtin_convertvector(v, at_bf16x2)); }
#define AT_BAR() do { asm volatile("s_waitcnt lgkmcnt(0)" ::: "memory"); __builtin_amdgcn_s_barrier(); asm volatile("" ::: "memory"); } while (0)
__device__ __forceinline__ void attn_unit(ldsp lds, const bf16* QK, const bf16* VT, bf16* MIX, const float* subln, float lam, int tokbase, int L, int h, int qb, int tid, int wid, int lane) {
    const int n = lane & 31, hi = lane >> 5, j = wid >> 2, g = wid & 3;
    const int q0 = qb * 128 + g * 32;
    bf16x8 qf[4];
    { const bf16* qp = QK + (size_t)(tokbase + q0 + n) * D + (2 * h + j) * 64 + hi * 8;
#pragma unroll
      for (int kk = 0; kk < 4; ++kk) qf[kk] = *(const bf16x8*)(qp + 16 * kk); }
#define qf_(kk) qf[kk]
    const int kkey0 = tid >> 4, kc = tid & 15;
    const int vdv0 = tid >> 3, vc = tid & 7;
    const __amdgpu_buffer_rsrc_t rk = __builtin_amdgcn_make_buffer_rsrc((void*)(QK + (size_t)tokbase * D), (short)0, L * 2048, 0x00020000);
    const __amdgpu_buffer_rsrc_t rv = __builtin_amdgcn_make_buffer_rsrc((void*)(VT + (size_t)(h * 128) * TT + tokbase), (short)0, 128 * TT * 2, 0x00020000);
    const int kvo0 = kkey0 * 2048 + (512 + h * 128 + kc * 8) * 2, kvo1 = kvo0 + 32 * 2048, vvo0 = vdv0 * (TT * 2) + vc * 16, vvo1 = vvo0 + 64 * (TT * 2);
    const unsigned klo = kkey0 * AT_KP + kc * 16, vlo = AT_V0 + vdv0 * AT_VP + (vc >> 1) * 32 + (vc & 1) * 8;
    const int NT = L >> 6;
    v4u kr0, kr1, vr0, vr1;
#define AT_BL(r, vo, so) __builtin_bit_cast(v4u, __builtin_amdgcn_raw_buffer_load_b128(r, vo, so, 0))
#define AT_LDK(t) do { const int so_ = (t) * 131072; kr0 = AT_BL(rk, kvo0, so_); kr1 = AT_BL(rk, kvo1, so_); } while (0)
#define AT_LDV(t) do { const int so_ = (t) * 128; vr0 = AT_BL(rv, vvo0, so_); vr1 = AT_BL(rv, vvo1, so_); } while (0)
#define AT_WRK(t) do { const unsigned bo = ((t) & 1) * AT_KB; *(LAS v4u*)(lds + bo + klo) = kr0; *(LAS v4u*)(lds + bo + klo + 32 * AT_KP) = kr1; } while (0)
#define AT_WRV(t) do { const unsigned bo = ((t) & 1) * AT_VB; *(LAS u32x2*)(lds + bo + vlo) = (u32x2){vr0.x, vr0.y}; *(LAS u32x2*)(lds + bo + vlo + 16) = (u32x2){vr0.z, vr0.w}; \
        *(LAS u32x2*)(lds + bo + vlo + 64 * AT_VP) = (u32x2){vr1.x, vr1.y}; *(LAS u32x2*)(lds + bo + vlo + 64 * AT_VP + 16) = (u32x2){vr1.z, vr1.w}; } while (0)
#define AT_MF(a, b, c) __builtin_amdgcn_mfma_f32_32x32x16_bf16(a, b, c, 0, 0, 0)
#define AT_B8(x) __builtin_bit_cast(bf16x8, x)
    AT_LDK(0); vr0 = AT_BL(rk, kvo0, 131072); vr1 = AT_BL(rk, kvo1, 131072);
    AT_WRK(0); *(LAS v4u*)(lds + AT_KB + klo) = vr0; *(LAS v4u*)(lds + AT_KB + klo + 32 * AT_KP) = vr1;
    for (int i = tid; i < AT_VB / 16; i += 512) *(LAS v4u*)(lds + AT_V0 + AT_VB + i * 16) = (v4u){0u, 0u, 0u, 0u};
    AT_BAR();
    f32x16 o[4] = {}; float m_reg = -1e30f, l_reg = 0.f;
    constexpr float C = 0.125f * 1.4426950408889634f;
    const unsigned kro = n * AT_KP + j * 128 + hi * 16, vro = AT_V0 + n * AT_VP + hi * 16;
    f32x16 sa0, sa1, sb0, sb1; bf16x8 pba[4] = {}, pbb[4] = {};
    {
        const unsigned kb = kro;
        sa0 = AT_MF(*(const LAS bf16x8*)(lds + kb), qf_(0), (f32x16){}); sa1 = AT_MF(*(const LAS bf16x8*)(lds + kb + 32 * AT_KP), qf_(0), (f32x16){});
#pragma unroll
        for (int kk = 1; kk < 4; ++kk) { sa0 = AT_MF(*(const LAS bf16x8*)(lds + kb + kk * 32), qf_(kk), sa0); sa1 = AT_MF(*(const LAS bf16x8*)(lds + kb + 32 * AT_KP + kk * 32), qf_(kk), sa1); }
    }
#define AT_SB() __builtin_amdgcn_sched_barrier(0)
#define AT_SPV(c, SP0, SP1) ((((c) >> 2) < 2) ? (f32x2){SP0[8 * (((c) >> 2) & 1) + 2 * ((c) & 3)], SP0[8 * (((c) >> 2) & 1) + 2 * ((c) & 3) + 1]} : (f32x2){SP1[8 * (((c) >> 2) & 1) + 2 * ((c) & 3)], SP1[8 * (((c) >> 2) & 1) + 2 * ((c) & 3) + 1]})
#define AT_FMA(c, SP0, SP1) do { const f32x2 sp_ = AT_SPV(c, SP0, SP1); float a_ = fmaf(sp_.x, C, mC_); asm volatile("" : "+v"(a_)); const float b_ = fmaf(sp_.y, C, mC_); xs_[(c) & 1] = (f32x2){a_, b_}; } while (0)
#define AT_EXP(c) do { ev_[(c) & 1].x = __builtin_amdgcn_exp2f(xs_[(c) & 1].x); ev_[(c) & 1].y = __builtin_amdgcn_exp2f(xs_[(c) & 1].y); } while (0)
#define AT_ACC(c) do { ps0_ += ev_[(c) & 1].x; ps1_ += ev_[(c) & 1].y; asm volatile("" : "+v"(ps0_), "+v"(ps1_)); wn_[(c) >> 2][(c) & 3] = at_cvtpk(ev_[(c) & 1]); } while (0)
#define AT_VF(dt, s_) (*(const LAS v4u*)(lds + vb_ + (dt) * 32 * AT_VP + (s_) * 32))
#define AT_KF(kk, hf) (*(const LAS v4u*)(lds + kb_ + (hf) * 32 * AT_KP + (kk) * 32))
#define AT_ITER(t, SP0, SP1, SQ0, SQ1, PBO, PBN) do { \
        const unsigned kb_ = (((t) + 1) & 1) * AT_KB + kro, vb_ = (((t) + 1) & 1) * AT_VB + vro; \
        v4u fa[4], fb[4], wn_[4]; f32x2 xs_[2], ev_[2]; float ps0_ = 0.f, ps1_ = 0.f; \
        fa[0] = AT_VF(0, 0); fa[1] = AT_VF(0, 1); fa[2] = AT_VF(0, 2); fa[3] = AT_VF(0, 3); \
        float pm0_ = fmaxf(SP0[0], SP1[0]); \
        _Pragma("unroll") for (int r = 1; r < 8; ++r) pm0_ = fmaxf(fmaxf(pm0_, SP0[r]), SP1[r]); \
        AT_SB(); \
        o[0] = AT_MF(AT_B8(fa[0]), PBO[0], o[0]); fb[0] = AT_VF(1, 0); { const int tk_ = (t) + 2 < NT ? (t) + 2 : NT - 1; AT_LDK(tk_); } float pmax_ = fmaxf(SP0[8], SP1[8]); _Pragma("unroll") for (int r = 9; r < 16; ++r) pmax_ = fmaxf(fmaxf(pmax_, SP0[r]), SP1[r]); pmax_ = fmaxf(pmax_, pm0_); pmax_ = fmaxf(pmax_, __shfl_xor(pmax_, 32)); AT_SB(); \
        o[0] = AT_MF(AT_B8(fa[1]), PBO[1], o[0]); fb[1] = AT_VF(1, 1); AT_LDV(t); const bool need_ = !__all((pmax_ - m_reg) * C <= 8.0f); const float mn_ = need_ ? fmaxf(m_reg, pmax_) : m_reg, mC_ = -mn_ * C; AT_FMA(0, SP0, SP1); AT_SB(); \
        o[0] = AT_MF(AT_B8(fa[2]), PBO[2], o[0]); fb[2] = AT_VF(1, 2); AT_EXP(0); AT_FMA(1, SP0, SP1); AT_SB(); \
        o[0] = AT_MF(AT_B8(fa[3]), PBO[3], o[0]); fb[3] = AT_VF(1, 3); AT_EXP(1); AT_ACC(0); AT_FMA(2, SP0, SP1); AT_SB(); \
        o[1] = AT_MF(AT_B8(fb[0]), PBO[0], o[1]); fa[0] = AT_VF(2, 0); AT_EXP(2); AT_ACC(1); AT_FMA(3, SP0, SP1); AT_SB(); \
        o[1] = AT_MF(AT_B8(fb[1]), PBO[1], o[1]); fa[1] = AT_VF(2, 1); AT_EXP(3); AT_ACC(2); AT_FMA(4, SP0, SP1); AT_SB(); \
        o[1] = AT_MF(AT_B8(fb[2]), PBO[2], o[1]); fa[2] = AT_VF(2, 2); AT_EXP(4); AT_ACC(3); AT_FMA(5, SP0, SP1); AT_SB(); \
        o[1] = AT_MF(AT_B8(fb[3]), PBO[3], o[1]); fa[3] = AT_VF(2, 3); AT_EXP(5); AT_ACC(4); AT_FMA(6, SP0, SP1); AT_SB(); \
        o[2] = AT_MF(AT_B8(fa[0]), PBO[0], o[2]); fb[0] = AT_VF(3, 0); AT_EXP(6); AT_ACC(5); AT_FMA(7, SP0, SP1); AT_SB(); \
        o[2] = AT_MF(AT_B8(fa[1]), PBO[1], o[2]); fb[1] = AT_VF(3, 1); AT_EXP(7); AT_ACC(6); AT_FMA(8, SP0, SP1); AT_SB(); \
        o[2] = AT_MF(AT_B8(fa[2]), PBO[2], o[2]); fb[2] = AT_VF(3, 2); AT_EXP(8); AT_ACC(7); AT_FMA(9, SP0, SP1); AT_SB(); \
        o[2] = AT_MF(AT_B8(fa[3]), PBO[3], o[2]); fb[3] = AT_VF(3, 3); AT_EXP(9); AT_ACC(8); AT_FMA(10, SP0, SP1); AT_SB(); \
        o[3] = AT_MF(AT_B8(fb[0]), PBO[0], o[3]); fa[0] = AT_KF(0, 0); AT_EXP(10); AT_ACC(9); AT_FMA(11, SP0, SP1); AT_SB(); \
        o[3] = AT_MF(AT_B8(fb[1]), PBO[1], o[3]); fa[1] = AT_KF(0, 1); AT_EXP(11); AT_ACC(10); AT_FMA(12, SP0, SP1); AT_SB(); \
        o[3] = AT_MF(AT_B8(fb[2]), PBO[2], o[3]); fa[2] = AT_KF(1, 0); AT_EXP(12); AT_ACC(11); AT_FMA(13, SP0, SP1); AT_SB(); \
        o[3] = AT_MF(AT_B8(fb[3]), PBO[3], o[3]); fa[3] = AT_KF(1, 1); bf16x8 qa_ = qf_(0); AT_EXP(13); AT_ACC(12); AT_FMA(14, SP0, SP1); AT_SB(); \
        SQ0 = AT_MF(AT_B8(fa[0]), qa_, (f32x16){}); fb[0] = AT_KF(2, 0); AT_EXP(14); AT_ACC(13); AT_FMA(15, SP0, SP1); AT_SB(); \
        SQ1 = AT_MF(AT_B8(fa[1]), qa_, (f32x16){}); fb[1] = AT_KF(2, 1); bf16x8 qb_ = qf_(1); AT_EXP(15); AT_ACC(14); AT_SB(); \
        SQ0 = AT_MF(AT_B8(fa[2]), qb_, SQ0); fb[2] = AT_KF(3, 0); AT_ACC(15); AT_SB(); \
        SQ1 = AT_MF(AT_B8(fa[3]), qb_, SQ1); fb[3] = AT_KF(3, 1); qa_ = qf_(2); AT_SB(); \
        SQ0 = AT_MF(AT_B8(fb[0]), qa_, SQ0); AT_WRK(t); AT_WRV(t); AT_SB();     \
        SQ1 = AT_MF(AT_B8(fb[1]), qa_, SQ1); qb_ = qf_(3); AT_SB(); \
        SQ0 = AT_MF(AT_B8(fb[2]), qb_, SQ0); AT_SB(); \
        SQ1 = AT_MF(AT_B8(fb[3]), qb_, SQ1); AT_SB(); \
        PBN[0] = AT_B8(wn_[0]); PBN[1] = AT_B8(wn_[1]); PBN[2] = AT_B8(wn_[2]); PBN[3] = AT_B8(wn_[3]); \
        if (need_) { const float alpha_ = __builtin_amdgcn_exp2f((m_reg - mn_) * C); l_reg *= alpha_; _Pragma("unroll") for (int dt = 0; dt < 4; ++dt) o[dt] = o[dt] * alpha_; } \
        l_reg += ps0_ + ps1_; m_reg = mn_; \
        AT_BAR(); \
    } while (0)
    for (int t = 0; t < NT; t += 2) {
        AT_ITER(t, sa0, sa1, sb0, sb1, pba, pbb);
        AT_ITER(t + 1, sb0, sb1, sa0, sa1, pbb, pba);
    }
    {
        const unsigned vb_ = AT_VB + vro;
#pragma unroll
        for (int dt = 0; dt < 4; ++dt)
#pragma unroll
            for (int s_ = 0; s_ < 4; ++s_) { const v4u aw = *(const LAS v4u*)(lds + vb_ + dt * 32 * AT_VP + s_ * 32);
                o[dt] = AT_MF(AT_B8(aw), pba[s_], o[dt]); }
    }
    AT_BAR();
#undef AT_BL
#undef AT_LDK
#undef AT_LDV
#undef AT_WRK
#undef AT_WRV
#undef AT_MF
#undef AT_B8
#undef AT_SB
#undef AT_SPV
#undef AT_FMA
#undef AT_EXP
#undef AT_ACC
#undef AT_VF
#undef AT_KF
#undef AT_ITER
#undef qf_
    const float linv = 1.f / (l_reg + __shfl_xor(l_reg, 32));
    LAS float* ex = (LAS float*)(lds + AT_EX) + (size_t)(g * 32 + n) * AT_EXP;
    if (j == 1) {
        const float sc = linv * lam;
#pragma unroll
        for (int t = 0; t < 4; ++t)
#pragma unroll
            for (int r4 = 0; r4 < 4; ++r4) { const int dv = 32 * t + 8 * r4 + 4 * hi;
                *(LAS f32x4*)(ex + dv) = (f32x4){o[t][4 * r4] * sc, o[t][4 * r4 + 1] * sc, o[t][4 * r4 + 2] * sc, o[t][4 * r4 + 3] * sc}; }
    }
    __syncthreads();
    if (j == 0) {
        float ss = 0.f;
#pragma unroll
        for (int t = 0; t < 4; ++t)
#pragma unroll
            for (int r4 = 0; r4 < 4; ++r4) { const int dv = 32 * t + 8 * r4 + 4 * hi; const f32x4 e = *(const LAS f32x4*)(ex + dv);
#pragma unroll
                for (int k = 0; k < 4; ++k) { const float v = o[t][4 * r4 + k] * linv - e[k]; o[t][4 * r4 + k] = v; ss += v * v; } }
        ss += __shfl_xor(ss, 32);
        const float rs = 0.8f / sqrtf(ss * (1.f / 128.f) + 1e-5f);
        bf16* orow = MIX + (size_t)(tokbase + q0 + n) * D + 512 + h * 128;
#pragma unroll
        for (int t = 0; t < 4; ++t)
#pragma unroll
            for (int p2 = 0; p2 < 2; ++p2) {
                u32x2 eo[2];
#pragma unroll
                for (int q = 0; q < 2; ++q) { const int r4 = 2 * p2 + q, dv = 32 * t + 8 * r4 + 4 * hi; const f32x4 w = *(const f32x4*)(subln + dv);
                    eo[q].x = pk2(o[t][4 * r4] * rs * w.x, o[t][4 * r4 + 1] * rs * w.y); eo[q].y = pk2(o[t][4 * r4 + 2] * rs * w.z, o[t][4 * r4 + 3] * rs * w.w); }
                const auto sx = __builtin_amdgcn_permlane32_swap(eo[0].x, eo[1].x, false, false), sy = __builtin_amdgcn_permlane32_swap(eo[0].y, eo[1].y, false, false);
                const v4u ov = {sx[0], sy[0], sx[1], sy[1]};
                *(v4u*)(orow + 32 * t + 8 * (2 * p2 + hi)) = ov; }
    }
    __syncthreads();
}
__global__ void __launch_bounds__(512, 2) hymba_fwd(Args a) {
    extern __shared__ __attribute__((aligned(16))) unsigned char lds_raw[];
    cg::grid_group grid = cg::this_grid();
    const ldsp lds = (ldsp)lds_raw;
    const int tid = threadIdx.x, lane = tid & 63, wid = __builtin_amdgcn_readfirstlane(tid >> 6);
    const int G = gridDim.x, bx = blockIdx.x, gw = bx * 8 + wid, NGW = G * 8;
    unsigned char* ws = a.ws;
    bf16* WIN = (bf16*)(ws + WS_WIN); bf16* WOUT = (bf16*)(ws + WS_WOUT); bf16* W1 = (bf16*)(ws + WS_W1); bf16* W2 = (bf16*)(ws + WS_W2);
    float* MOD = (float*)(ws + WS_MOD); float* ROT = (float*)(ws + WS_ROT); bf16* KRP = (bf16*)(ws + WS_KRP); bf16* KRS = (bf16*)(ws + WS_KRS);
    bf16* XN = (bf16*)(ws + WS_XN); bf16* UT = (bf16*)(ws + WS_UT); bf16* QK = (bf16*)(ws + WS_QK); bf16* VT = (bf16*)(ws + WS_VT); bf16* YT = (bf16*)(ws + WS_YT);
    bf16* HB = (bf16*)(ws + WS_H); bf16* MIX = XN;
    const int lo = a.ph_lo, hi_ = a.ph_hi;
#ifndef PHMASK
#define PHMASK 0xffffffffu
#endif
#define IN(k) (((PHMASK >> ((k) < PH_MLP0 ? (k) : ((k) == PH_FINAL ? 9 : 7 + (((k) - PH_MLP0) & 1)))) & 1u) && lo <= (k) && (k) < hi_)
#define SEAM(k) do { if (IN(k) && IN((k) + 1)) grid.sync(); } while (0)

    if (IN(PH_P0)) {
#ifndef P0_NO_ADALN
        for (int it = bx; it < 6144 / 64; it += G) adaln_item(lds, a, MOD, it, tid, wid, lane);
#endif
        LAS float* scr = (LAS float*)(lds + wid * 16384);
        constexpr int I_IN = (D / 64) * (DIN / 32), I_O = (D / 64) * (D / 32), I_1 = (D / 64) * (FF / 32), I_2 = (FF / 64) * (D / 32), NTR = I_IN + I_O + I_1 + I_2;
        constexpr int I_FP = L_P / 32, I_FS = L_S / 32;
#ifndef P0_NO_FILT
        for (int it = NGW - 1 - gw; it < 3 * (I_FP + I_FS); it += NGW) { const int q = it / 3, part = it - 3 * q, np0 = part == 0 ? 0 : (part == 1 ? 6 : 11), npn = part == 0 ? 6 : 5;
            if (q < I_FP) filter_item32(a, L_P, KRP, 32 * q, np0, npn, lane); else filter_item32(a, L_S, KRS, 32 * (q - I_FP), np0, npn, lane); }
#endif
        for (int it = gw; it < NTR; it += NGW) {
            int r = it;
            if (r < I_IN) { p0_transpose_item(a.in[7], D, DIN, WIN, 0, scr, r, lane); continue; } r -= I_IN;
            if (r < I_O) { p0_transpose_item(a.in[25], D, D, WOUT, 0, scr, r, lane); continue; } r -= I_O;
            if (r < I_1) { p0_transpose_item(a.in[27], D, FF, W1, 0, scr, r, lane); continue; } r -= I_1;
            p0_transpose_item(a.in[28], FF, D, W2, 0, scr, r, lane);
        }
#ifndef P0_NO_ROT
        for (int idx = bx * 512 + tid; idx < L_P * 8; idx += G * 512) { const int pos = idx >> 3, i = idx & 7;
            const float invf = powf(500000.0f, -(float)i / 8.0f); const float ang = (float)pos * invf;
            ROT[pos * 16 + i] = (float)cos((double)ang); ROT[pos * 16 + 8 + i] = (float)sin((double)ang); }
#endif
    }
    SEAM(PH_P0);
    if (IN(PH_XN1)) {
        for (int row = gw; row < TT; row += 2 * NGW) { const int rb_ = row + NGW; const int mb = batch_of_row(row); const float* xr = row < T_P ? a.in[0] + (size_t)row * D : a.in[1] + (size_t)(row - T_P) * D;
            if (rb_ < TT) { const int mb2 = batch_of_row(rb_); const float* xr2 = rb_ < T_P ? a.in[0] + (size_t)rb_ * D : a.in[1] + (size_t)(rb_ - T_P) * D;
                norm_row2<0>(xr, xr2, a.in[6], MOD + mb * 6144 + 1024, MOD + mb * 6144, MOD + mb2 * 6144 + 1024, MOD + mb2 * 6144, XN + (size_t)row * D, XN + (size_t)rb_ * D, nullptr, nullptr, 1e-6f, lane); }
            else norm_row<0>(xr, a.in[6], MOD + mb * 6144 + 1024, MOD + mb * 6144, XN + (size_t)row * D, nullptr, 1e-6f, lane); }
    }
    SEAM(PH_XN1);
    if (IN(PH_INPROJ)) {
        { pg8::Gemm g{WIN, XN, 1536, TT, D}; pg8::StaticOrder S; S.init(1536, TT, G, bx); pg8::EpiBf16<0, false> E{UT, TT, nullptr};
          pg8::gemm_phase<pg8::EpiBf16<0, false>, pg8::StaticOrder, PG8_ALIGN, PG8_SP2>(lds, g, S, E); }
        __syncthreads();
        { pg8::Gemm g{XN, WIN + (size_t)1536 * D, TT, 1024, D}; pg8::StaticOrder S; S.init(TT, 1024, G, bx); pg8::EpiBf16<0, true> E{QK, 1024, ROT};
          pg8::gemm_phase<pg8::EpiBf16<0, true>, pg8::StaticOrder, PG8_ALIGN, PG8_SP2>(lds, g, S, E); }
        __syncthreads();
        { pg8::Gemm g{WIN + (size_t)2560 * D, XN, 512, TT, D}; pg8::StaticOrder S; S.init(512, TT, G, bx); pg8::EpiBf16<0, false> E{VT, TT, nullptr};
          pg8::gemm_phase<pg8::EpiBf16<0, false>, pg8::StaticOrder, PG8_ALIGN, PG8_SP2>(lds, g, S, E); }
    }
    SEAM(PH_INPROJ);
    if (IN(PH_MIX)) {
        for (int u = bx; u < HW + 2 * HW; u += G) hyena_unit(lds, a, UT, KRP, KRS, YT, u, tid, wid, lane);
        const float lam = expf(wave_sum(a.in[20][lane] * a.in[21][lane])) - expf(wave_sum(a.in[22][lane] * a.in[23][lane])) + 0.2f;
        for (int u = bx; u < 1024 + 2048; u += G) {
            int mb, h, qb, tokbase, L;
            if (G == 256) {
                const int x = bx & 7, c = bx >> 3, r = u >> 8;
                if (r < 4) { mb = x >> 2; h = x & 3; qb = c + 32 * r; tokbase = mb * L_P; L = L_P; }
                else { const int w = c + 32 * (r - 4), p = (w >> 4) * 8 + x; mb = p >> 2; h = p & 3; qb = w & 15; tokbase = T_P + mb * L_S; L = L_S; }
            } else if (u < 1024) { mb = u >> 9; h = (u >> 7) & 3; qb = u & 127; tokbase = mb * L_P; L = L_P; }
            else { const int v = u - 1024; mb = v >> 6; h = (v >> 4) & 3; qb = v & 15; tokbase = T_P + mb * L_S; L = L_S; }
            attn_unit(lds, QK, VT, MIX, a.in[24], lam, tokbase, L, h, qb, tid, wid, lane);
        }
    }
    SEAM(PH_MIX);
    if (IN(PH_HNORM)) hnorm_phase(lds, a, YT, MIX, bx, G, tid, wid, lane);
    SEAM(PH_HNORM);
    if (IN(PH_OUTPROJ)) {
        pg8::Gemm g{MIX, WOUT, TT, D, D}; pg8::StaticOrder S; S.init(TT, D, G, bx); pg8::EpiGateRes E{a.in[0], a.in[1], a.out, MOD + 2048, 0};
        pg8::gemm_phase<pg8::EpiGateRes, pg8::StaticOrder, PG8_ALIGN, PG8_SP2>(lds, g, S, E);
    }
    SEAM(PH_OUTPROJ);
    if (IN(PH_XN2)) {
        for (int row = gw; row < TT; row += 2 * NGW) { const int rb_ = row + NGW; const int mb = batch_of_row(row);
            if (rb_ < TT) { const int mb2 = batch_of_row(rb_);
                norm_row2<0>(a.out + (size_t)row * D, a.out + (size_t)rb_ * D, a.in[26], MOD + mb * 6144 + 4096, MOD + mb * 6144 + 3072, MOD + mb2 * 6144 + 4096, MOD + mb2 * 6144 + 3072, XN + (size_t)row * D, XN + (size_t)rb_ * D, nullptr, nullptr, 1e-6f, lane); }
            else norm_row<0>(a.out + (size_t)row * D, a.in[26], MOD + mb * 6144 + 4096, MOD + mb * 6144 + 3072, XN + (size_t)row * D, nullptr, 1e-6f, lane); }
    }
    SEAM(PH_XN2);
    for (int ch = 0; ch < N_CHUNK; ++ch) {
        if (IN(PH_MLP0 + 2 * ch)) {
            pg8::Gemm g{XN + (size_t)ch * MLP_CHUNK * D, W1, MLP_CHUNK, FF, D}; pg8::StaticOrder S; S.init(MLP_CHUNK, FF, G, bx); pg8::EpiBf16<2, false> E{HB, FF, nullptr};
            pg8::gemm_phase<pg8::EpiBf16<2, false>, pg8::StaticOrder, PG8_ALIGN, PG8_SP2>(lds, g, S, E);
        }
        SEAM(PH_MLP0 + 2 * ch);
        if (IN(PH_MLP0 + 2 * ch + 1)) {
            pg8::Gemm g{HB, W2, MLP_CHUNK, D, FF}; pg8::StaticOrder S; S.init(MLP_CHUNK, D, G, bx); pg8::EpiGateRes E{nullptr, nullptr, a.out, MOD + 5120, ch * MLP_CHUNK};
            pg8::gemm_phase<pg8::EpiGateRes, pg8::StaticOrder, PG8_ALIGN, PG8_SP2>(lds, g, S, E);
        }
        SEAM(PH_MLP0 + 2 * ch + 1);
    }
    if (IN(PH_FINAL)) {
        for (int row = gw; row < TT; row += 2 * NGW) { const int rb_ = row + NGW;
            if (rb_ < TT) norm_row2<1>(a.out + (size_t)row * D, a.out + (size_t)rb_ * D, a.in[29], nullptr, nullptr, nullptr, nullptr, nullptr, nullptr, a.out + (size_t)row * D, a.out + (size_t)rb_ * D, 1e-6f, lane);
            else norm_row<1>(a.out + (size_t)row * D, a.in[29], nullptr, nullptr, nullptr, a.out + (size_t)row * D, 1e-6f, lane); }
    }
#undef IN
#undef SEAM
}

#ifndef MK_PER_PHASE
#define MK_PER_PHASE 0
#endif
extern "C" void kernel_launch(void* const* d_in, const int* in_sizes, int n_in, void* d_out, int out_size, void* d_ws, size_t ws_size, hipStream_t stream) {
    static int grid = 0;
    if (grid == 0) {
        if (n_in != 30 || out_size != TT * D || ws_size < WS_END) { fprintf(stderr, "kernel_launch: unexpected shapes (n_in %d out %d ws %zu)\n", n_in, out_size, ws_size); grid = -1; return; }
        int dev = 0, cus = 0, per_cu = 0;
        hipGetDevice(&dev); hipDeviceGetAttribute(&cus, hipDeviceAttributeMultiprocessorCount, dev);
        if (hipFuncSetAttribute((const void*)hymba_fwd, hipFuncAttributeMaxDynamicSharedMemorySize, LDS_BYTES) != hipSuccess) { fprintf(stderr, "kernel_launch: hipFuncSetAttribute failed\n"); grid = -1; return; }
        if (hipOccupancyMaxActiveBlocksPerMultiprocessor(&per_cu, (const void*)hymba_fwd, 512, LDS_BYTES) != hipSuccess || per_cu < 1) { fprintf(stderr, "kernel_launch: occupancy query says %d\n", per_cu); per_cu = 1; }
        (void)hipGetLastError();
        grid = cus * per_cu;
    }
    if (grid < 0) return;
    Args a{};
    for (int i = 0; i < 30; ++i) a.in[i] = (const float*)d_in[i];
    a.out = (float*)d_out; a.ws = (unsigned char*)d_ws;
#if MK_PER_PHASE
    for (int p = 0; p < N_PHASES; ++p) { a.ph_lo = p; a.ph_hi = p + 1; void* args[] = {&a};
        hipError_t e = hipLaunchCooperativeKernel((const void*)hymba_fwd, dim3(grid), dim3(512), args, LDS_BYTES, stream);
        if (e != hipSuccess) { fprintf(stderr, "launch %d failed: %s\n", p, hipGetErrorString(e)); break; } }
#else
    a.ph_lo = 0; a.ph_hi = N_PHASES; void* args[] = {&a};
    hipError_t e = hipLaunchCooperativeKernel((const void*)hymba_fwd, dim3(grid), dim3(512), args, LDS_BYTES, stream);
    if (e != hipSuccess) fprintf(stderr, "cooperative launch failed: %s (grid %d)\n", hipGetErrorString(e), grid);
#endif
}
```

```cpp
#include <hip/hip_runtime.h>
#include <hip/hip_cooperative_groups.h>
#include <cstdio>
#include <cstdint>
namespace cg = cooperative_groups;
namespace pg8 {
#define PG8_LAS __attribute__((address_space(3)))
typedef unsigned short bf16_t;
typedef short bf16x8 __attribute__((ext_vector_type(8)));
typedef float f32x4 __attribute__((ext_vector_type(4)));
typedef unsigned u32x4 __attribute__((ext_vector_type(4)));
constexpr int BM = 256, BK = 64, HALF = 128, HTB = HALF * BK * 2  , STAGE_BYTES = 8 * HTB, NXCD = 8, WGM = 8;

__host__ __device__ __forceinline__ int lds_byte(int r, int c) { const int st = (r >> 4) * 2 + (c >> 5), rr = r & 15, cc = c & 31, ob = rr * 64 + cc * 2; return st * 1024 + (ob ^ (((ob >> 9) & 1) << 5)); }
__host__ __device__ __forceinline__ void stage_rc(int b, int& R, int& C) { const int st = b / 1024, sb = b % 1024, swz = sb ^ (((sb >> 9) & 1) << 5); R = (st >> 1) * 16 + swz / 64; C = (st & 1) * 32 + (swz % 64) / 2; }
__host__ __device__ __forceinline__ int perm32(int rho) { const int n = rho >> 4, i = rho & 15; return 8 * (i >> 2) + 4 * n + (i & 3); }

struct Unit { int pm, pn; };
struct Gemm { const bf16_t* A; const bf16_t* Bt; int M, N, K; };

struct StaticOrder {
    int nM, nN, nwg, G, c;
    __host__ __device__ void init(int M, int N, int G_, int c_) { nM = M / BM; nN = N / BM; nwg = nM * nN; G = G_; c = c_; }
    __host__ __device__ bool next(int i, Unit& u) const {
        const long L = (long)i * G + c; if (L >= nwg) return false;
        int wgid = (int)L; { const int q = nwg / NXCD, r = nwg % NXCD, xcd = wgid % NXCD, off = wgid / NXCD; wgid = (xcd < r ? xcd * (q + 1) : r * (q + 1) + (xcd - r) * q) + off; }
        const int nig = WGM * nN, gid = wgid / nig, fm = gid * WGM, gsz = (nM - fm) < WGM ? (nM - fm) : WGM;
        u.pm = fm + ((wgid % nig) % gsz); u.pn = (wgid % nig) / gsz; return true;
    }
    __device__ __forceinline__ void a_ready(const Unit&) const {}
    __device__ __forceinline__ void done(const Unit&) const {}
};

typedef __bf16 pg8_bf16x2 __attribute__((ext_vector_type(2))); typedef float pg8_f32x2 __attribute__((ext_vector_type(2)));
__device__ __forceinline__ unsigned cvt_pk_bf16(float lo, float hi) { const pg8_f32x2 v = {lo, hi}; return __builtin_bit_cast(unsigned, __builtin_convertvector(v, pg8_bf16x2)); }
template <int ACT, bool ROT> struct EpiBf16 {
    static constexpr bool PERM = true, AFTER_DRAIN = false;
    bf16_t* O; int ldc; const float* rot;
    __device__ __forceinline__ void operator()(const f32x4 (&acc)[2][2][4][2], const Unit& u, int wr, int wc, int fr, int fq) const {
        const int row0 = u.pm * BM + wr * 64 + fr;
        const int col0 = u.pn * BM + wc * 32 + 8 * fq;
#pragma unroll
        for (int ai = 0; ai < 2; ++ai)
#pragma unroll
            for (int m = 0; m < 4; ++m) {
                const int row = row0 + ai * HALF + m * 16;
                bf16_t* rowp = O + (size_t)row * ldc + col0;
                f32x4 c0 = {1.f, 1.f, 1.f, 1.f}, c1 = c0, s0 = {0.f, 0.f, 0.f, 0.f}, s1 = s0;
                if (ROT) { if ((wc & 1) == 0 && fq < 2) { const int pos = row < 32768 ? (row & 16383) : (row & 2047); const f32x4* tp = (const f32x4*)(rot + (size_t)pos * 16);
                        c0 = tp[0]; c1 = tp[1]; s0 = tp[2]; s1 = tp[3]; if (fq == 0) { s0 = -s0; s1 = -s1; } } }
#pragma unroll
                for (int bj = 0; bj < 2; ++bj) { f32x4 v0 = acc[ai][bj][m][0], v1 = acc[ai][bj][m][1];
                    if (ACT == 2) {
#pragma unroll
                        for (int e = 0; e < 4; ++e) { const float a0 = fmaxf(v0[e], 0.f), a1 = fmaxf(v1[e], 0.f); v0[e] = a0 * a0; v1[e] = a1 * a1; } }
                    if (ROT) { if ((wc & 1) == 0) { f32x4 p0, p1;
#pragma unroll
                            for (int e = 0; e < 4; ++e) { p0[e] = __shfl_xor(v0[e], 16); p1[e] = __shfl_xor(v1[e], 16); }
                            v0 = v0 * c0 + p0 * s0; v1 = v1 * c1 + p1 * s1; } }
                    u32x4 w; w.x = cvt_pk_bf16(v0[0], v0[1]); w.y = cvt_pk_bf16(v0[2], v0[3]); w.z = cvt_pk_bf16(v1[0], v1[1]); w.w = cvt_pk_bf16(v1[2], v1[3]);
                    *(u32x4*)(rowp + bj * HALF) = w; } }
    }
};
struct EpiGateRes {
    static constexpr bool PERM = false, AFTER_DRAIN = false;
    const float* xp; const float* xs; float* out; const float* gate; int row_off;
    __device__ __forceinline__ void operator()(const f32x4 (&acc)[2][2][4][2], const Unit& u, int wr, int wc, int fr, int fq) const {
        const int grow0 = row_off + u.pm * BM;
        const int mb = grow0 < 32768 ? (grow0 >> 14) : 2 + ((grow0 - 32768) >> 11);
        const int col0 = u.pn * BM + wc * 32 + 4 * fq;
        const float* gp = gate + (size_t)mb * 6144 + col0;
        f32x4 gv[2][2];
#pragma unroll
        for (int bj = 0; bj < 2; ++bj)
#pragma unroll
            for (int n = 0; n < 2; ++n) gv[bj][n] = *(const f32x4*)(gp + bj * HALF + n * 16);
#pragma unroll
        for (int ai = 0; ai < 2; ++ai)
#pragma unroll
            for (int m = 0; m < 4; ++m) { const int row = grow0 + ai * HALF + wr * 64 + m * 16 + fr;
                const float* bp = (xp ? (row < 32768 ? xp + (size_t)row * 1024 : xs + (size_t)(row - 32768) * 1024) : out + (size_t)row * 1024) + col0;
                float* op = out + (size_t)row * 1024 + col0;
#pragma unroll
                for (int bj = 0; bj < 2; ++bj)
#pragma unroll
                    for (int n = 0; n < 2; ++n) { const f32x4 b = *(const f32x4*)(bp + bj * HALF + n * 16); *(f32x4*)(op + bj * HALF + n * 16) = b + gv[bj][n] * acc[ai][bj][m][n]; }
                if (m & 1) asm volatile("" ::: "memory"); }
    }
};
template <class Epi, class Sched, bool ALIGN_EPI = false, bool SP2 = false>
__device__ __forceinline__ void gemm_phase(PG8_LAS unsigned char* lds, const Gemm g, const Sched& S, const Epi& E) {
    int tid_ = threadIdx.x; asm volatile("" : "+v"(tid_));
    const int tid = tid_, wid = __builtin_amdgcn_readfirstlane(tid >> 6), lane = tid & 63, wr = wid >> 2, wc = wid & 3, fr = lane & 15, fq = lane >> 4;
    const int K = g.K, nt = K / BK;
    unsigned voffA[2], voffB[2];
#pragma unroll
    for (int i = 0; i < 2; ++i) { int R, C; stage_rc(tid * 16 + i * 8192, R, C); const int Rb = Epi::PERM ? ((R & ~31) + perm32(R & 31)) : R;
        voffA[i] = (unsigned)(R * K + C) * 2u; voffB[i] = (unsigned)(Rb * K + C) * 2u; }
    const size_t kstep = (size_t)(BK * 2);
    const size_t hstep = (size_t)HALF * K * 2;
    const size_t tstep = 2 * hstep;
    const unsigned ldsw = (unsigned)wid * 1024u;
    const int aoff = lds_byte(wr * 64 + fr, fq * 8), boff = lds_byte(wc * 32 + fr, fq * 8);
#define PG8_SA(b, h) (((b) * 2 + (h)) * HTB)
#define PG8_SB(b, h) ((4 + (b) * 2 + (h)) * HTB)
#define PG8_STAGE(bufoff, gbase, voff) do { _Pragma("unroll") for (int _i = 0; _i < 2; ++_i) \
        __builtin_amdgcn_global_load_lds((const unsigned*)((const char*)(gbase) + (voff)[_i]), (PG8_LAS unsigned*)(lds + (bufoff) + ldsw + _i * 8192), 16, 0, 0); } while (0)
#define PG8_LDA(dst, b, h) do { _Pragma("unroll") for (int m = 0; m < 4; ++m) _Pragma("unroll") for (int k = 0; k < 2; ++k) dst[m][k] = *(const PG8_LAS bf16x8*)(lds + PG8_SA(b, h) + aoff + m * 2048 + k * 1024); } while (0)
#define PG8_LDB(dst, b, h) do { _Pragma("unroll") for (int n = 0; n < 2; ++n) _Pragma("unroll") for (int k = 0; k < 2; ++k) dst[n][k] = *(const PG8_LAS bf16x8*)(lds + PG8_SB(b, h) + boff + n * 2048 + k * 1024); } while (0)
#define PG8_MMA(ai, bj, At, Bt) do { __builtin_amdgcn_s_setprio(1); _Pragma("unroll") for (int m = 0; m < 4; ++m) _Pragma("unroll") for (int n = 0; n < 2; ++n) _Pragma("unroll") for (int k = 0; k < 2; ++k) \
        acc[ai][bj][m][n] = __builtin_amdgcn_mfma_f32_16x16x32_bf16(Bt[n][k], At[m][k], acc[ai][bj][m][n], 0, 0, 0); __builtin_amdgcn_s_setprio(0); } while (0)
#define PG8_WAIT_V(n) asm volatile("s_waitcnt vmcnt(" #n ")" ::: "memory")
#define PG8_WAIT_L(n) asm volatile("s_waitcnt lgkmcnt(" #n ")" ::: "memory")
#define PG8_BAR __builtin_amdgcn_s_barrier()
#define PG8_SCHED __builtin_amdgcn_sched_barrier(0)
    Unit cur, nxt; int ui = 0;
    if (!S.next(0, cur)) return;
    f32x4 acc[2][2][4][2];
#pragma unroll
    for (int a = 0; a < 2; ++a)
#pragma unroll
        for (int b = 0; b < 2; ++b)
#pragma unroll
            for (int m = 0; m < 4; ++m)
#pragma unroll
                for (int n = 0; n < 2; ++n) acc[a][b][m][n] = (f32x4){0.f, 0.f, 0.f, 0.f};
    bf16x8 At[4][2], B0[2][2], B1[2][2];
    const char* cA = (const char*)g.A + (size_t)cur.pm * tstep; const char* cB = (const char*)g.Bt + (size_t)cur.pn * tstep;
    S.a_ready(cur);
    if constexpr (SP2) {
        PG8_STAGE(PG8_SB(0, 0), cB, voffB); PG8_STAGE(PG8_SB(0, 1), cB + hstep, voffB); PG8_STAGE(PG8_SA(0, 0), cA, voffA); PG8_STAGE(PG8_SA(0, 1), cA + hstep, voffA);
        if (wr == 1) PG8_BAR;
        PG8_WAIT_V(2); PG8_BAR;
        PG8_STAGE(PG8_SB(1, 0), cB + kstep, voffB); PG8_STAGE(PG8_SA(1, 0), cA + kstep, voffA); PG8_STAGE(PG8_SB(1, 1), cB + hstep + kstep, voffB);
        PG8_WAIT_V(6); PG8_BAR;
    } else {
        PG8_STAGE(PG8_SB(0, 0), cB, voffB); PG8_STAGE(PG8_SA(0, 0), cA, voffA); PG8_STAGE(PG8_SB(0, 1), cB + hstep, voffB); PG8_STAGE(PG8_SA(0, 1), cA + hstep, voffA);
        if (wr == 1) PG8_BAR;
        PG8_WAIT_V(4); PG8_BAR;
        PG8_STAGE(PG8_SB(1, 0), cB + kstep, voffB); PG8_STAGE(PG8_SA(1, 0), cA + kstep, voffA); PG8_STAGE(PG8_SB(1, 1), cB + hstep + kstep, voffB);
        PG8_WAIT_V(6); PG8_BAR;
    }
    for (;;) {
        const bool has_next = S.next(ui + 1, nxt);
        const char* nA = has_next ? (const char*)g.A + (size_t)nxt.pm * tstep : cA; const char* nB = has_next ? (const char*)g.Bt + (size_t)nxt.pn * tstep : cB;
        for (int t = 0; t < nt; t += 2) {
            const bool last = (t == nt - 2);
            const char* a1 = cA + (size_t)(t + 1) * kstep;
            const char* a2 = last ? nA : cA + (size_t)(t + 2) * kstep; const char* b2 = last ? nB : cB + (size_t)(t + 2) * kstep;
            const char* a3 = a2 + kstep; const char* b3 = b2 + kstep;
            if (last && has_next) S.a_ready(nxt);
            if constexpr (SP2) {
            PG8_LDB(B0, 0, 0); PG8_LDB(B1, 0, 1); PG8_SCHED; PG8_LDA(At, 0, 0); PG8_STAGE(PG8_SA(1, 1), a1 + hstep, voffA);
            PG8_WAIT_V(8); PG8_WAIT_L(0); PG8_BAR; PG8_MMA(0, 0, At, B0); PG8_MMA(0, 1, At, B1); PG8_BAR; PG8_SCHED;
            PG8_LDA(At, 0, 1); PG8_STAGE(PG8_SB(0, 0), b2, voffB); PG8_STAGE(PG8_SB(0, 1), b2 + hstep, voffB); PG8_STAGE(PG8_SA(0, 0), a2, voffA);
            PG8_WAIT_V(8); PG8_WAIT_L(0); PG8_BAR; PG8_MMA(1, 0, At, B0); PG8_MMA(1, 1, At, B1); PG8_BAR; PG8_SCHED;
            PG8_LDB(B0, 1, 0); PG8_LDB(B1, 1, 1); PG8_SCHED; PG8_LDA(At, 1, 0); PG8_STAGE(PG8_SA(0, 1), a2 + hstep, voffA);
            PG8_WAIT_V(8); PG8_WAIT_L(0); PG8_BAR; PG8_MMA(0, 0, At, B0); PG8_MMA(0, 1, At, B1); PG8_BAR; PG8_SCHED;
            PG8_LDA(At, 1, 1); PG8_STAGE(PG8_SB(1, 0), b3, voffB); PG8_STAGE(PG8_SB(1, 1), b3 + hstep, voffB); PG8_STAGE(PG8_SA(1, 0), a3, voffA);
            PG8_WAIT_V(8); PG8_WAIT_L(0); PG8_BAR; PG8_MMA(1, 0, At, B0); PG8_MMA(1, 1, At, B1); PG8_BAR; PG8_SCHED;
            } else {
            PG8_LDB(B0, 0, 0); PG8_SCHED; PG8_LDA(At, 0, 0); PG8_STAGE(PG8_SA(1, 1), a1 + hstep, voffA);
            PG8_WAIT_L(8); PG8_BAR; PG8_WAIT_L(0); PG8_MMA(0, 0, At, B0); PG8_BAR; PG8_SCHED;
            PG8_LDB(B1, 0, 1); PG8_STAGE(PG8_SB(0, 0), b2, voffB);
            PG8_BAR; PG8_WAIT_L(0); PG8_MMA(0, 1, At, B1); PG8_BAR;
            PG8_LDA(At, 0, 1); PG8_STAGE(PG8_SA(0, 0), a2, voffA);
            PG8_BAR; PG8_WAIT_L(0); PG8_MMA(1, 0, At, B0); PG8_BAR; PG8_SCHED;
            PG8_STAGE(PG8_SB(0, 1), b2 + hstep, voffB);
            PG8_WAIT_V(6); PG8_BAR; PG8_MMA(1, 1, At, B1); PG8_BAR;
            PG8_LDB(B0, 1, 0); PG8_SCHED; PG8_LDA(At, 1, 0); PG8_STAGE(PG8_SA(0, 1), a2 + hstep, voffA);
            PG8_WAIT_L(8); PG8_BAR; PG8_WAIT_L(0); PG8_MMA(0, 0, At, B0); PG8_BAR; PG8_SCHED;
            PG8_LDB(B1, 1, 1); PG8_STAGE(PG8_SB(1, 0), b3, voffB);
            PG8_BAR; PG8_WAIT_L(0); PG8_MMA(0, 1, At, B1); PG8_BAR;
            PG8_LDA(At, 1, 1); PG8_STAGE(PG8_SA(1, 0), a3, voffA);
            PG8_BAR; PG8_WAIT_L(0); PG8_MMA(1, 0, At, B0); PG8_BAR; PG8_SCHED;
            PG8_STAGE(PG8_SB(1, 1), b3 + hstep, voffB);
            PG8_WAIT_V(6); PG8_BAR; PG8_MMA(1, 1, At, B1); PG8_BAR;
            }
        }
        if constexpr (ALIGN_EPI) { if (wr == 0) PG8_BAR; }
        if constexpr (!Epi::AFTER_DRAIN) { E(acc, cur, wr, wc, fr, fq); S.done(cur); }
        if (!has_next) break;
#pragma unroll
        for (int a = 0; a < 2; ++a)
#pragma unroll
            for (int b = 0; b < 2; ++b)
#pragma unroll
                for (int m = 0; m < 4; ++m)
#pragma unroll
                    for (int n = 0; n < 2; ++n) acc[a][b][m][n] = (f32x4){0.f, 0.f, 0.f, 0.f};
        cur = nxt; cA = nA; cB = nB; ++ui;
        if constexpr (ALIGN_EPI) { if (wr == 1) PG8_BAR; }
    }
    PG8_WAIT_V(0);
    if constexpr (!ALIGN_EPI) { if (wr == 0) PG8_BAR; }
    PG8_BAR;
    if constexpr (Epi::AFTER_DRAIN) { E.fused(acc, cur, wr, wc, fr, fq, lds, wid, lane); S.done(cur); }
#undef PG8_SA
#undef PG8_SB
#undef PG8_STAGE
#undef PG8_LDA
#undef PG8_LDB
#undef PG8_MMA
#undef PG8_WAIT_V
#undef PG8_WAIT_L
#undef PG8_BAR
#undef PG8_SCHED
}
}
#ifndef PG8_SP2
#define PG8_SP2 true
#endif
#ifndef PG8_ALIGN
#define PG8_ALIGN true
#endif
constexpr int D = 1024, T_P = 32768, T_S = 65536, TT = T_P + T_S, L_P = 16384, L_S = 2048, NB_ROWS = 34, DIN = 3072, FF = 4096, HW = 512;
constexpr size_t MiB = 1u << 20;
constexpr size_t WS_WIN = 2 * MiB, WS_WOUT = 8 * MiB, WS_W1 = 10 * MiB, WS_W2 = 18 * MiB, WS_MOD = 26 * MiB, WS_ROT = 27 * MiB, WS_KRP = 28 * MiB, WS_KRS = 60 * MiB,
                 WS_XN = 64 * MiB, WS_UT = 256 * MiB, WS_QK = 544 * MiB, WS_VT = 736 * MiB, WS_YT = 832 * MiB, WS_END = 928 * MiB, WS_H = WS_UT;
constexpr int MLP_CHUNK = 49152, N_CHUNK = TT / MLP_CHUNK;
constexpr int LDS_BYTES = 147456;
constexpr int PH_P0 = 0, PH_XN1 = 1, PH_INPROJ = 2, PH_MIX = 3, PH_HNORM = 4, PH_OUTPROJ = 5, PH_XN2 = 6, PH_MLP0 = 7, PH_FINAL = PH_MLP0 + 2 * N_CHUNK, N_PHASES = PH_FINAL + 1;

#define GAS __attribute__((address_space(1)))
#define LAS __attribute__((address_space(3)))
typedef unsigned short bf16;
typedef unsigned v4u __attribute__((ext_vector_type(4)));
typedef unsigned u32x2 __attribute__((ext_vector_type(2)));
typedef float f32x4 __attribute__((ext_vector_type(4)));
typedef float f32x16 __attribute__((ext_vector_type(16)));
typedef short bf16x8 __attribute__((ext_vector_type(8)));
typedef short s16x4 __attribute__((ext_vector_type(4)));
typedef LAS unsigned char* ldsp;
#define LDS_WAIT() asm volatile("s_waitcnt lgkmcnt(0)" ::: "memory")
__device__ __forceinline__ unsigned f2bf(float f) { unsigned u = __builtin_bit_cast(unsigned, f); return (u + 0x7fffu + ((u >> 16) & 1u)) >> 16; }
__device__ __forceinline__ unsigned pk2(float lo, float hi) { return f2bf(lo) | (f2bf(hi) << 16); }
__device__ __forceinline__ float bflo(unsigned w) { return __builtin_bit_cast(float, w << 16); }
__device__ __forceinline__ float bfhi(unsigned w) { return __builtin_bit_cast(float, w & 0xffff0000u); }
__device__ __forceinline__ float bf2f(unsigned short b) { return __builtin_bit_cast(float, ((unsigned)b) << 16); }
__device__ __forceinline__ float wave_sum(float v) {
#pragma unroll
    for (int o = 1; o < 64; o <<= 1) v += __shfl_xor(v, o);
    return v;
}
__device__ __forceinline__ float rdlane(float v, int i) { return __builtin_bit_cast(float, __builtin_amdgcn_readlane(__builtin_bit_cast(int, v), i)); }
__device__ __forceinline__ int batch_of_row(int row) { return row < T_P ? (row >> 14) : 2 + ((row - T_P) >> 11); }

struct Args { const float* in[30]; float* out; unsigned char* ws; int ph_lo, ph_hi; };

__device__ __forceinline__ void p0_transpose_item(const float* W, int K, int N, bf16* WT, int row_off, LAS float* scr, int item, int lane) {
    const int nblk = N / 32, kb = item / nblk, nb = item % nblk, k0 = 64 * kb, n0 = 32 * nb;
    float tv[32];
#pragma unroll
    for (int i = 0; i < 32; ++i) tv[i] = W[(size_t)(k0 + 2 * i + (lane >> 5)) * N + n0 + (lane & 31)];
#pragma unroll
    for (int i = 0; i < 32; ++i) scr[(2 * i + (lane >> 5)) * 33 + (lane & 31)] = tv[i];
    LDS_WAIT(); asm volatile("" ::: "memory");
    const int c = lane & 7;
#pragma unroll
    for (int j = 0; j < 4; ++j) { const int n = (lane >> 3) + 8 * j; const LAS float* s = scr + (8 * c) * 33 + n;
        v4u o; o.x = pk2(s[0 * 33], s[1 * 33]); o.y = pk2(s[2 * 33], s[3 * 33]); o.z = pk2(s[4 * 33], s[5 * 33]); o.w = pk2(s[6 * 33], s[7 * 33]);
        *(GAS v4u*)(WT + (size_t)(row_off + n0 + n) * K + k0 + 8 * c) = o; }
    LDS_WAIT(); asm volatile("" ::: "memory");
}
__device__ __forceinline__ void adaln_item(ldsp lds, const Args& a, float* MOD, int item, int tid, int wid, int lane) {
    LAS float* sc = (LAS float*)lds;
    const float* cp = a.in[2]; const float* cs = a.in[3];
    for (int idx = tid; idx < NB_ROWS * D; idx += 512) { const int r = idx >> 10, k = idx & 1023; const float x = r < 2 ? cp[r * D + k] : cs[(r - 2) * D + k]; sc[idx] = x / (1.f + expf(-x)); }
    __syncthreads();
    const int n0 = item * 64; const float* W = a.in[4] + n0 + lane;
    float acc[NB_ROWS];
#pragma unroll
    for (int r = 0; r < NB_ROWS; ++r) acc[r] = 0.f;
    for (int k = wid * 128; k < wid * 128 + 128; k += 4) {
        const float w0 = W[(size_t)k * 6144], w1 = W[(size_t)(k + 1) * 6144], w2 = W[(size_t)(k + 2) * 6144], w3 = W[(size_t)(k + 3) * 6144];
#pragma unroll
        for (int r = 0; r < NB_ROWS; ++r) { const f32x4 s = *(const LAS f32x4*)(sc + r * D + k); acc[r] += (s.x * w0 + s.y * w1) + (s.z * w2 + s.w * w3); }
    }
    __syncthreads();
    LAS float* part = (LAS float*)lds;
#pragma unroll
    for (int r = 0; r < NB_ROWS; ++r) part[(wid * NB_ROWS + r) * 64 + lane] = acc[r];
    __syncthreads();
    for (int r = wid; r < NB_ROWS; r += 8) { float s = a.in[5][n0 + lane];
#pragma unroll
        for (int p = 0; p < 8; ++p) s += part[(p * NB_ROWS + r) * 64 + lane];
        MOD[(size_t)r * 6144 + n0 + lane] = s; }
    __syncthreads();
}

__device__ __forceinline__ int crow16(int r, int hi) { return (r & 3) + 8 * (r >> 2) + 4 * hi; }
__device__ __forceinline__ void filter_item32(const Args& a, int L, bf16* KR, int t0, int np0, int npn, int lane) {
    const float *w1 = a.in[10], *b1 = a.in[11], *w2 = a.in[12], *b2 = a.in[13], *w3 = a.in[14], *b3 = a.in[15], *w4 = a.in[16], *fq = a.in[17];
    const int n = lane & 31, hi = lane >> 5, t = t0 + n;
    const float tt = (float)t * (1.0f / (float)(L - 1)), w = 6.283185307179586f * (float)t / (float)L;
    f32x16 h0 = {}, h1 = {};
    {
        float cv[8], sv[8];
#pragma unroll
        for (int k = 0; k < 8; ++k) { const float f = 1e-4f + (float)(k + 8 * hi) * ((15.0f - 1e-4f) / 15.0f); float s, c; sincosf(f * w, &s, &c); cv[k] = c; sv[k] = -s; }
#pragma unroll
        for (int kk = 0; kk < 17; ++kk) {
            const int urow = kk < 8 ? 1 + kk : (kk < 16 ? 17 + (kk - 8) : 0);
            const float zb = kk < 8 ? cv[kk & 7] : (kk < 16 ? sv[kk & 7] : (hi == 0 ? tt : 0.f));
            const float* ub = w1 + urow * 64; const int lo1 = kk < 16 ? 8 * hi * 64 + n : n;
            const float a0 = ub[lo1], a1 = ub[lo1 + 32];
            h0 = __builtin_amdgcn_mfma_f32_32x32x2f32(a0, zb, h0, 0, 0, 0); h1 = __builtin_amdgcn_mfma_f32_32x32x2f32(a1, zb, h1, 0, 0, 0);
        }
#pragma unroll
        for (int r = 0; r < 16; ++r) { const int j = crow16(r, hi); h0[r] = sinf(fq[j] * (h0[r] + b1[j])); h1[r] = sinf(fq[32 + j] * (h1[r] + b1[32 + j])); }
    }
#pragma unroll
    for (int layer = 0; layer < 2; ++layer) {
        const float* W = layer ? w3 : w2; const float* bb = layer ? b3 : b2;
        f32x16 g0 = {}, g1 = {}; const int lo2 = 4 * hi * 64 + n;
#pragma unroll
        for (int kk = 0; kk < 32; ++kk) {
            const float* ub = W + (32 * (kk >> 4) + crow16(kk & 15, 0)) * 64;
            const float zb = kk < 16 ? h0[kk & 15] : h1[kk & 15];
            const float a0 = ub[lo2], a1 = ub[lo2 + 32];
            g0 = __builtin_amdgcn_mfma_f32_32x32x2f32(a0, zb, g0, 0, 0, 0); g1 = __builtin_amdgcn_mfma_f32_32x32x2f32(a1, zb, g1, 0, 0, 0);
        }
#pragma unroll
        for (int r = 0; r < 16; ++r) { const int j = crow16(r, hi); h0[r] = sinf(fq[j] * (g0[r] + bb[j])); h1[r] = sinf(fq[32 + j] * (g1[r] + bb[32 + j])); }
    }
    const float dmin = -3.0701134573253943f, dmax = -15.350567286626972f;
#pragma unroll 1
    for (int np = np0; np < np0 + npn; ++np) {
        f32x16 of = {}, ob = {};
        const float* wr = w4 + 32 * np; const int lo4 = 4 * hi * 1024 + n;
#pragma unroll
        for (int kk = 0; kk < 32; ++kk) {
            const float* ub = wr + (32 * (kk >> 4) + crow16(kk & 15, 0)) * 1024;
            const float zb = kk < 16 ? h0[kk & 15] : h1[kk & 15];
            const float af = ub[lo4], ab = ub[lo4 + 512];
            of = __builtin_amdgcn_mfma_f32_32x32x2f32(af, zb, of, 0, 0, 0); ob = __builtin_amdgcn_mfma_f32_32x32x2f32(ab, zb, ob, 0, 0, 0);
        }
#pragma unroll
        for (int r = 0; r < 16; ++r) { const int c = 32 * np + crow16(r, hi); const float ad = -(dmin + (float)c * ((dmax - dmin) / 511.0f));
            const float dec = expf(-tt * ad); bf16* kr = KR + (size_t)c * (2 * L);
            if (t == 0) { kr[L] = (bf16)f2bf(of[r] + ob[r]); kr[0] = 0; } else { kr[L - t] = (bf16)f2bf(of[r] * dec); kr[L + t] = (bf16)f2bf(ob[r] * dec); } }
    }
}

template <int MODE> __device__ __forceinline__ void norm_row(const float* xrow, const float* nw, const float* sc, const float* sh, bf16* orow, float* frow, float eps, int lane) {
    const f32x4* xr = (const f32x4*)xrow + lane;
    f32x4 v[4]; float s = 0.f;
#pragma unroll
    for (int j = 0; j < 4; ++j) { v[j] = xr[64 * j]; s += (v[j].x * v[j].x + v[j].y * v[j].y) + (v[j].z * v[j].z + v[j].w * v[j].w); }
    const float r = 1.f / sqrtf(wave_sum(s) * (1.f / D) + eps);
#pragma unroll
    for (int j = 0; j < 4; ++j) { const f32x4 w = ((const f32x4*)nw)[64 * j + lane]; f32x4 y = v[j] * r * w;
        if (MODE == 0) { const f32x4 c = ((const f32x4*)sc)[64 * j + lane], h = ((const f32x4*)sh)[64 * j + lane]; y = y * (c + 1.f) + h;
            u32x2 o; o.x = pk2(y.x, y.y); o.y = pk2(y.z, y.w); ((u32x2*)orow)[64 * j + lane] = o; }
        else ((f32x4*)frow)[64 * j + lane] = y; }
}
template <int MODE> __device__ __forceinline__ void norm_row2(const float* xa, const float* xb, const float* nw, const float* sca, const float* sha, const float* scb, const float* shb,
                                                              bf16* oa, bf16* ob, float* fa_, float* fb_, float eps, int lane) {
    const f32x4* pa = (const f32x4*)xa + lane; const f32x4* pb = (const f32x4*)xb + lane;
    f32x4 va[4], vb[4]; float s0 = 0.f, s1 = 0.f;
#pragma unroll
    for (int j = 0; j < 4; ++j) { va[j] = pa[64 * j]; vb[j] = pb[64 * j]; }
#pragma unroll
    for (int j = 0; j < 4; ++j) { s0 += (va[j].x * va[j].x + va[j].y * va[j].y) + (va[j].z * va[j].z + va[j].w * va[j].w); s1 += (vb[j].x * vb[j].x + vb[j].y * vb[j].y) + (vb[j].z * vb[j].z + vb[j].w * vb[j].w); }
#pragma unroll
    for (int o = 1; o < 64; o <<= 1) { s0 += __shfl_xor(s0, o); s1 += __shfl_xor(s1, o); }
    const float r0 = 1.f / sqrtf(s0 * (1.f / D) + eps), r1 = 1.f / sqrtf(s1 * (1.f / D) + eps);
#pragma unroll
    for (int j = 0; j < 4; ++j) { const f32x4 w = ((const f32x4*)nw)[64 * j + lane]; f32x4 ya = va[j] * r0 * w, yb = vb[j] * r1 * w;
        if (MODE == 0) { const f32x4 ca = ((const f32x4*)sca)[64 * j + lane], ha = ((const f32x4*)sha)[64 * j + lane], cb = ((const f32x4*)scb)[64 * j + lane], hb = ((const f32x4*)shb)[64 * j + lane];
            ya = ya * (ca + 1.f) + ha; yb = yb * (cb + 1.f) + hb;
            u32x2 o; o.x = pk2(ya.x, ya.y); o.y = pk2(ya.z, ya.w); ((u32x2*)oa)[64 * j + lane] = o; o.x = pk2(yb.x, yb.y); o.y = pk2(yb.z, yb.w); ((u32x2*)ob)[64 * j + lane] = o; }
        else { ((f32x4*)fa_)[64 * j + lane] = ya; ((f32x4*)fb_)[64 * j + lane] = yb; } }
}
__device__ __forceinline__ void hyena_unit(ldsp lds, const Args& a, const bf16* UT, const bf16* KRP, const bf16* KRS, bf16* YT, int unit, int tid, int wid, int lane) {
    const bool pr = unit < HW;
    const int c = pr ? unit : ((unit - HW) >> 1), half = pr ? 0 : ((unit - HW) & 1);
    const int L = pr ? L_P : L_S, Nb = L >> 5, nseq = pr ? 2 : 16;
    const int SP = (Nb + 64) * 64;
    const int HY_SOFF = 4 * L + 64;
    const bf16* KR = (pr ? KRP : KRS) + (size_t)c * (2 * L);
    { const int nz = (nseq * SP) >> 4; for (int i = tid; i < nz; i += 512) *(LAS v4u*)(lds + HY_SOFF + i * 16) = (v4u){0u, 0u, 0u, 0u};
      if (tid < 4) *(LAS v4u*)(lds + 4 * L + tid * 16) = (v4u){0u, 0u, 0u, 0u}; }
    { const int nc = (4 * L) >> 4; for (int i = tid; i < nc; i += 512) *(LAS v4u*)(lds + i * 16) = *(const v4u*)((const char*)KR + (size_t)i * 16); }
    __syncthreads();
    const float* cw = a.in[8]; const float* cb = a.in[9];
    {
        const float a0 = cw[HW + c], a1 = cw[1536 + HW + c], a2 = cw[3072 + HW + c], ab = cb[HW + c];
        const float v0 = cw[2 * HW + c], v1 = cw[1536 + 2 * HW + c], v2 = cw[3072 + 2 * HW + c], vb = cb[2 * HW + c];
        const int gps = L >> 3, total = nseq * gps;
        (void)total;
#pragma unroll
        for (int bt = 0; bt < 2; ++bt) {
            v4u r1[4], r2[4]; unsigned short h1m[4], h1p[4], h2m[4], h2p[4]; int tq[4], sq_[4];
#pragma unroll
            for (int q = 0; q < 4; ++q) {
                const int g = tid + 512 * (4 * bt + q); const int seq = g / gps, tg = g - seq * gps, t = tg << 3; tq[q] = t; sq_[q] = seq;
                const size_t tok = (size_t)(pr ? seq * L_P : T_P + (half * 16 + seq) * L_S) + t;
                const bf16* p1 = UT + (size_t)(HW + c) * TT + tok; const bf16* p2 = UT + (size_t)(2 * HW + c) * TT + tok;
                r1[q] = *(const v4u*)p1; r2[q] = *(const v4u*)p2;
                const int im = t > 0 ? -1 : 0, ip = t + 8 < L ? 8 : 7;
                h1m[q] = p1[im]; h2m[q] = p2[im]; h1p[q] = p1[ip]; h2p[q] = p2[ip];
            }
#pragma unroll
            for (int q = 0; q < 4; ++q) {
                const int t = tq[q], seq = sq_[q]; const v4u ra = r1[q], rb2 = r2[q];
                float x[10], y[10];
                x[0] = t > 0 ? bf2f(h1m[q]) : 0.f; y[0] = t > 0 ? bf2f(h2m[q]) : 0.f;
                x[9] = t + 8 < L ? bf2f(h1p[q]) : 0.f; y[9] = t + 8 < L ? bf2f(h2p[q]) : 0.f;
                x[1] = bflo(ra.x); x[2] = bfhi(ra.x); x[3] = bflo(ra.y); x[4] = bfhi(ra.y); x[5] = bflo(ra.z); x[6] = bfhi(ra.z); x[7] = bflo(ra.w); x[8] = bfhi(ra.w);
                y[1] = bflo(rb2.x); y[2] = bfhi(rb2.x); y[3] = bflo(rb2.y); y[4] = bfhi(rb2.y); y[5] = bflo(rb2.z); y[6] = bfhi(rb2.z); y[7] = bflo(rb2.w); y[8] = bfhi(rb2.w);
                float sv[8];
#pragma unroll
                for (int e = 0; e < 8; ++e) sv[e] = (a0 * x[e] + a1 * x[e + 1] + a2 * x[e + 2] + ab) * (v0 * y[e] + v1 * y[e + 1] + v2 * y[e + 2] + vb);
                v4u o; o.x = pk2(sv[0], sv[1]); o.y = pk2(sv[2], sv[3]); o.z = pk2(sv[4], sv[5]); o.w = pk2(sv[6], sv[7]);
                const int r = 32 + (t >> 5), ci = (t & 31) >> 3;
                *(LAS v4u*)(lds + HY_SOFF + seq * SP + r * 64 + ((ci ^ ((r >> 2) & 3)) << 4)) = o;
            }
        }
    }
    __syncthreads();
    const int n = lane & 31, hi = lane >> 5;
    const int i0 = pr ? 64 * wid : 0, sq0 = pr ? 0 : 2 * wid, sq1 = sq0 + 1;
    const unsigned sb0 = HY_SOFF + sq0 * SP, sb1 = HY_SOFF + sq1 * SP;
    f32x16 acc00 = {}, acc01 = {}, acc10 = {}, acc11 = {};
    unsigned Xd[2][5], Yd[2][5]; v4u Xb0[2][2], Xb1[2][2], Yb0[2][2], Yb1[2][2];
    const unsigned hy_sh = (unsigned)(n & 1) << 4, hy_ab = (unsigned)(((L - n + 8 * hi) >> 1) * 4); const int hy_rb = 32 + i0 + n;
#define HY_LOAD(dd, T0, T1, P) do { const int dq_ = (dd); \
        const LAS unsigned* fp = (const LAS unsigned*)(lds + (hy_ab - 64u * (unsigned)dq_)); \
        _Pragma("unroll") for (int kk = 0; kk < 2; ++kk) { P##d[kk][0] = fp[8 * kk]; P##d[kk][1] = fp[8 * kk + 1]; P##d[kk][2] = fp[8 * kk + 2]; P##d[kk][3] = fp[8 * kk + 3]; P##d[kk][4] = fp[8 * kk + 4]; } \
        const int r0_ = hy_rb - dq_; const unsigned off0_ = ((unsigned)r0_ << 6) + ((((unsigned)r0_ >> 2) & 3u) ^ (unsigned)hi) * 16u, off1_ = off0_ ^ 32u; \
        if (T0) { P##b0[0][0] = *(const LAS v4u*)(lds + sb0 + off0_); P##b0[0][1] = *(const LAS v4u*)(lds + sb1 + off0_); P##b0[1][0] = *(const LAS v4u*)(lds + sb0 + off1_); P##b0[1][1] = *(const LAS v4u*)(lds + sb1 + off1_); } \
        if (T1) { P##b1[0][0] = *(const LAS v4u*)(lds + sb0 + off0_ + 2048); P##b1[0][1] = *(const LAS v4u*)(lds + sb1 + off0_ + 2048); P##b1[1][0] = *(const LAS v4u*)(lds + sb0 + off1_ + 2048); P##b1[1][1] = *(const LAS v4u*)(lds + sb1 + off1_ + 2048); } } while (0)
#define HY_COMP(T0, T1, P) do { _Pragma("unroll") for (int kk = 0; kk < 2; ++kk) { const unsigned sh = hy_sh; v4u aw; \
        aw.x = __builtin_amdgcn_alignbit(P##d[kk][1], P##d[kk][0], sh); aw.y = __builtin_amdgcn_alignbit(P##d[kk][2], P##d[kk][1], sh); \
        aw.z = __builtin_amdgcn_alignbit(P##d[kk][3], P##d[kk][2], sh); aw.w = __builtin_amdgcn_alignbit(P##d[kk][4], P##d[kk][3], sh); \
        const bf16x8 A = __builtin_bit_cast(bf16x8, aw); \
        if (T0) { acc00 = __builtin_amdgcn_mfma_f32_32x32x16_bf16(A, __builtin_bit_cast(bf16x8, P##b0[kk][0]), acc00, 0, 0, 0); \
                  acc01 = __builtin_amdgcn_mfma_f32_32x32x16_bf16(A, __builtin_bit_cast(bf16x8, P##b0[kk][1]), acc01, 0, 0, 0); } \
        if (T1) { acc10 = __builtin_amdgcn_mfma_f32_32x32x16_bf16(A, __builtin_bit_cast(bf16x8, P##b1[kk][0]), acc10, 0, 0, 0); \
                  acc11 = __builtin_amdgcn_mfma_f32_32x32x16_bf16(A, __builtin_bit_cast(bf16x8, P##b1[kk][1]), acc11, 0, 0, 0); } } } while (0)
#define HY_SB() __builtin_amdgcn_sched_barrier(0)
#define HY_SEG(dlo, dhi, T0, T1) do { int d = (dlo); const int dh_ = (dhi); HY_LOAD(d, T0, T1, X); HY_SB(); \
        for (; d + 1 <= dh_; d += 2) { HY_LOAD(d + 1, T0, T1, Y); HY_SB(); HY_COMP(T0, T1, X); HY_SB(); \
            HY_LOAD((d + 2 <= dh_ ? d + 2 : dh_), T0, T1, X); HY_SB(); HY_COMP(T0, T1, Y); HY_SB(); } \
        if (d == dh_) { HY_COMP(T0, T1, X); HY_SB(); } } while (0)
    HY_SEG(i0 - Nb + 1, i0 + 32 - Nb, true, false);
    HY_SEG(i0 + 33 - Nb, i0 + 31, true, true);
    HY_SEG(i0 + 32, i0 + 63, false, true);
#undef HY_LOAD
#undef HY_COMP
#undef HY_SB
#undef HY_SEG
    {
        const float a0 = cw[c], a1 = cw[1536 + c], a2 = cw[3072 + c], ab = cb[c], hb = a.in[18][c];
#pragma unroll
        for (int ts = 0; ts < 4; ++ts) {
            const int tile = ts >> 1, sl = ts & 1; const f32x16 acc = ts == 0 ? acc00 : (ts == 1 ? acc01 : (ts == 2 ? acc10 : acc11));
            const int sq = sl ? sq1 : sq0; const int i = i0 + 32 * tile + n;
            const size_t tokb = (size_t)(pr ? sq * L_P : T_P + (half * 16 + sq) * L_S);
            const bf16* u0 = UT + (size_t)c * TT + tokb; bf16* yo = YT + (size_t)c * TT + tokb;
#pragma unroll
            for (int g4 = 0; g4 < 4; ++g4) {
                const int aa = 8 * g4 + 4 * hi, t = 32 * i + aa;
                const u32x2 ru = *(const u32x2*)(u0 + t);
                float x[6]; x[0] = t > 0 ? bf2f(u0[t - 1]) : 0.f; x[5] = t + 4 < L ? bf2f(u0[t + 4]) : 0.f;
                x[1] = bflo(ru.x); x[2] = bfhi(ru.x); x[3] = bflo(ru.y); x[4] = bfhi(ru.y);
                const int r = 32 + i, ci = aa >> 3;
                const u32x2 rs = *(const LAS u32x2*)(lds + HY_SOFF + sq * SP + r * 64 + ((ci ^ ((r >> 2) & 3)) << 4) + (aa & 7) * 2);
                const float s0 = bflo(rs.x), s1 = bfhi(rs.x), s2 = bflo(rs.y), s3 = bfhi(rs.y);
                const float y0 = (a0 * x[0] + a1 * x[1] + a2 * x[2] + ab) * (acc[4 * g4 + 0] + s0 * hb);
                const float y1 = (a0 * x[1] + a1 * x[2] + a2 * x[3] + ab) * (acc[4 * g4 + 1] + s1 * hb);
                const float y2 = (a0 * x[2] + a1 * x[3] + a2 * x[4] + ab) * (acc[4 * g4 + 2] + s2 * hb);
                const float y3 = (a0 * x[3] + a1 * x[4] + a2 * x[5] + ab) * (acc[4 * g4 + 3] + s3 * hb);
                u32x2 o; o.x = pk2(y0, y1); o.y = pk2(y2, y3); *(u32x2*)(yo + t) = o;
            }
        }
    }
    __syncthreads();
}

__device__ __forceinline__ void hnorm_phase(ldsp lds, const Args& a, const bf16* YT, bf16* MIX, int bx, int G, int tid, int wid, int lane) {
    LAS unsigned* tile = (LAS unsigned*)lds;
    const float* hw = a.in[19];
    constexpr int NIT = TT / 64;
    v4u pre[8];
    int it = bx;
    if (it < NIT) {
#pragma unroll
        for (int q = 0; q < 8; ++q) { const int idx = tid + 512 * q, c = idx >> 3, k = idx & 7; pre[q] = *(const v4u*)(YT + (size_t)c * TT + it * 64 + 8 * k); } }
    for (; it < NIT; it += G) {
        const int tok0 = it * 64;
#pragma unroll
        for (int q = 0; q < 8; ++q) { const int idx = tid + 512 * q, c = idx >> 3, k = idx & 7; LAS unsigned* p = tile + c * 33 + 4 * k; p[0] = pre[q].x; p[1] = pre[q].y; p[2] = pre[q].z; p[3] = pre[q].w; }
        __syncthreads();
        if (it + G < NIT) {
#pragma unroll
            for (int q = 0; q < 8; ++q) { const int idx = tid + 512 * q, c = idx >> 3, k = idx & 7; pre[q] = *(const v4u*)(YT + (size_t)c * TT + (it + G) * 64 + 8 * k); } }
        for (int tt = wid * 8; tt < wid * 8 + 8; ++tt) {
            float v[8]; float ss = 0.f;
#pragma unroll
            for (int e = 0; e < 8; ++e) { const unsigned w = tile[(e * 64 + lane) * 33 + (tt >> 1)]; v[e] = (tt & 1) ? bfhi(w) : bflo(w); ss += v[e] * v[e]; }
            const float r = 1.f / sqrtf(wave_sum(ss) * (1.f / HW) + 1e-6f);
            bf16* orow = MIX + (size_t)(tok0 + tt) * D;
#pragma unroll
            for (int e = 0; e < 8; ++e) orow[e * 64 + lane] = (bf16)f2bf(v[e] * r * hw[e * 64 + lane]);
        }
        __syncthreads();
    }
}

constexpr int AT_KP = 272, AT_VP = 144, AT_KB = 64 * AT_KP, AT_VB = 128 * AT_VP, AT_V0 = 2 * AT_KB, AT_EX = 2 * AT_KB + 2 * AT_VB, AT_EXP = 132;
typedef float f32x2 __attribute__((ext_vector_type(2)));
typedef __bf16 at_bf16x2 __attribute__((ext_vector_type(2)));
__device__ __forceinline__ unsigned at_cvtpk(f32x2 v) { return __builtin_bit_cast(unsigned, __builtin_convertvector(v, at_bf16x2)); }
#define AT_BAR() do { asm volatile("s_waitcnt lgkmcnt(0)" ::: "memory"); __builtin_amdgcn_s_barrier(); asm volatile("" ::: "memory"); } while (0)
__device__ __forceinline__ void attn_unit(ldsp lds, const bf16* QK, const bf16* VT, bf16* MIX, const float* subln, float lam, int tokbase, int L, int h, int qb, int tid, int wid, int lane) {
    const int n = lane & 31, hi = lane >> 5, j = wid >> 2, g = wid & 3;
    const int q0 = qb * 128 + g * 32;
    bf16x8 qf[4];
    { const bf16* qp = QK + (size_t)(tokbase + q0 + n) * D + (2 * h + j) * 64 + hi * 8;
#pragma unroll
      for (int kk = 0; kk < 4; ++kk) qf[kk] = *(const bf16x8*)(qp + 16 * kk); }
#define qf_(kk) qf[kk]
    const int kkey0 = tid >> 4, kc = tid & 15;
    const int vdv0 = tid >> 3, vc = tid & 7;
    const __amdgpu_buffer_rsrc_t rk = __builtin_amdgcn_make_buffer_rsrc((void*)(QK + (size_t)tokbase * D), (short)0, L * 2048, 0x00020000);
    const __amdgpu_buffer_rsrc_t rv = __builtin_amdgcn_make_buffer_rsrc((void*)(VT + (size_t)(h * 128) * TT + tokbase), (short)0, 128 * TT * 2, 0x00020000);
    const int kvo0 = kkey0 * 2048 + (512 + h * 128 + kc * 8) * 2, kvo1 = kvo0 + 32 * 2048, vvo0 = vdv0 * (TT * 2) + vc * 16, vvo1 = vvo0 + 64 * (TT * 2);
    const unsigned klo = kkey0 * AT_KP + kc * 16, vlo = AT_V0 + vdv0 * AT_VP + (vc >> 1) * 32 + (vc & 1) * 8;
    const int NT = L >> 6;
    v4u kAa, kAb, vAa, vAb, kBa, kBb, vBa, vBb;
#define AT_BL(r, vo, so) __builtin_bit_cast(v4u, __builtin_amdgcn_raw_buffer_load_b128(r, vo, so, 0))
#define AT_LDKS(S, t) do { const int so_ = (t) * 131072; k##S##a = AT_BL(rk, kvo0, so_); k##S##b = AT_BL(rk, kvo1, so_); } while (0)
#define AT_LDVS(S, t) do { const int so_ = (t) * 128; v##S##a = AT_BL(rv, vvo0, so_); v##S##b = AT_BL(rv, vvo1, so_); } while (0)
#define AT_WRKS(S, t) do { const unsigned bo = ((t) & 1) * AT_KB; *(LAS v4u*)(lds + bo + klo) = k##S##a; *(LAS v4u*)(lds + bo + klo + 32 * AT_KP) = k##S##b; } while (0)
#define AT_WRVS(S, t) do { const unsigned bo = ((t) & 1) * AT_VB; *(LAS u32x2*)(lds + bo + vlo) = (u32x2){v##S##a.x, v##S##a.y}; *(LAS u32x2*)(lds + bo + vlo + 16) = (u32x2){v##S##a.z, v##S##a.w}; \
        *(LAS u32x2*)(lds + bo + vlo + 64 * AT_VP) = (u32x2){v##S##b.x, v##S##b.y}; *(LAS u32x2*)(lds + bo + vlo + 64 * AT_VP + 16) = (u32x2){v##S##b.z, v##S##b.w}; } while (0)
#define AT_MF(a, b, c) __builtin_amdgcn_mfma_f32_32x32x16_bf16(a, b, c, 0, 0, 0)
#define AT_B8(x) __builtin_bit_cast(bf16x8, x)
    AT_LDKS(A, 0); AT_LDKS(B, 1);
    AT_WRKS(A, 0); AT_WRKS(B, 1);
    AT_LDKS(A, 2); AT_LDVS(A, 0);
    for (int i = tid; i < AT_VB / 16; i += 512) *(LAS v4u*)(lds + AT_V0 + AT_VB + i * 16) = (v4u){0u, 0u, 0u, 0u};
    AT_BAR();
    f32x16 o[4] = {}; float m_reg = -1e30f, l_reg = 0.f;
    constexpr float C = 0.125f * 1.4426950408889634f;
    const unsigned kro = n * AT_KP + j * 128 + hi * 16, vro = AT_V0 + n * AT_VP + hi * 16;
    f32x16 sa0, sa1, sb0, sb1; bf16x8 pba[4] = {}, pbb[4] = {};
    {
        const unsigned kb = kro;
        sa0 = AT_MF(*(const LAS bf16x8*)(lds + kb), qf_(0), (f32x16){}); sa1 = AT_MF(*(const LAS bf16x8*)(lds + kb + 32 * AT_KP), qf_(0), (f32x16){});
#pragma unroll
        for (int kk = 1; kk < 4; ++kk) { sa0 = AT_MF(*(const LAS bf16x8*)(lds + kb + kk * 32), qf_(kk), sa0); sa1 = AT_MF(*(const LAS bf16x8*)(lds + kb + 32 * AT_KP + kk * 32), qf_(kk), sa1); }
    }
#define AT_SB() __builtin_amdgcn_sched_barrier(0)
#define AT_SPV(c, SP0, SP1) ((((c) >> 2) < 2) ? (f32x2){SP0[8 * (((c) >> 2) & 1) + 2 * ((c) & 3)], SP0[8 * (((c) >> 2) & 1) + 2 * ((c) & 3) + 1]} : (f32x2){SP1[8 * (((c) >> 2) & 1) + 2 * ((c) & 3)], SP1[8 * (((c) >> 2) & 1) + 2 * ((c) & 3) + 1]})
#define AT_FMA(c, SP0, SP1) do { const f32x2 sp_ = AT_SPV(c, SP0, SP1); float a_ = fmaf(sp_.x, C, mC_); asm volatile("" : "+v"(a_)); const float b_ = fmaf(sp_.y, C, mC_); xs_[(c) & 1] = (f32x2){a_, b_}; } while (0)
#define AT_EXP(c) do { ev_[(c) & 1].x = __builtin_amdgcn_exp2f(xs_[(c) & 1].x); ev_[(c) & 1].y = __builtin_amdgcn_exp2f(xs_[(c) & 1].y); } while (0)
#define AT_ACC(c) do { ps0_ += ev_[(c) & 1].x; ps1_ += ev_[(c) & 1].y; asm volatile("" : "+v"(ps0_), "+v"(ps1_)); wn_[(c) >> 2][(c) & 3] = at_cvtpk(ev_[(c) & 1]); } while (0)
#define AT_VF(dt, s_) (*(const LAS v4u*)(lds + vb_ + (dt) * 32 * AT_VP + (s_) * 32))
#define AT_KF(kk, hf) (*(const LAS v4u*)(lds + kb_ + (hf) * 32 * AT_KP + (kk) * 32))
#define AT_ITER(t, SP0, SP1, SQ0, SQ1, PBO, PBN, WS, LS) do {     \
        const unsigned kb_ = (((t) + 1) & 1) * AT_KB + kro, vb_ = (((t) + 1) & 1) * AT_VB + vro; \
        v4u fa[4], fb[4], wn_[4]; f32x2 xs_[2], ev_[2]; float ps0_ = 0.f, ps1_ = 0.f; \
        fa[0] = AT_VF(0, 0); fa[1] = AT_VF(0, 1); fa[2] = AT_VF(0, 2); fa[3] = AT_VF(0, 3); \
        float pm0_ = fmaxf(SP0[0], SP1[0]); \
        _Pragma("unroll") for (int r = 1; r < 8; ++r) pm0_ = fmaxf(fmaxf(pm0_, SP0[r]), SP1[r]); \
        AT_SB(); \
        o[0] = AT_MF(AT_B8(fa[0]), PBO[0], o[0]); fb[0] = AT_VF(1, 0); { const int tk_ = (t) + 3 < NT ? (t) + 3 : NT - 1; AT_LDKS(LS, tk_); } float pmax_ = fmaxf(SP0[8], SP1[8]); _Pragma("unroll") for (int r = 9; r < 16; ++r) pmax_ = fmaxf(fmaxf(pmax_, SP0[r]), SP1[r]); pmax_ = fmaxf(pmax_, pm0_); pmax_ = fmaxf(pmax_, __shfl_xor(pmax_, 32)); AT_SB(); \
        o[0] = AT_MF(AT_B8(fa[1]), PBO[1], o[0]); fb[1] = AT_VF(1, 1); { const int tv_ = (t) + 1 < NT ? (t) + 1 : NT - 1; AT_LDVS(LS, tv_); } const bool need_ = !__all((pmax_ - m_reg) * C <= 8.0f); const float mn_ = need_ ? fmaxf(m_reg, pmax_) : m_reg, mC_ = -mn_ * C; AT_FMA(0, SP0, SP1); AT_SB(); \
        o[0] = AT_MF(AT_B8(fa[2]), PBO[2], o[0]); fb[2] = AT_VF(1, 2); AT_EXP(0); AT_FMA(1, SP0, SP1); AT_SB(); \
        o[0] = AT_MF(AT_B8(fa[3]), PBO[3], o[0]); fb[3] = AT_VF(1, 3); AT_EXP(1); AT_ACC(0); AT_FMA(2, SP0, SP1); AT_SB(); \
        o[1] = AT_MF(AT_B8(fb[0]), PBO[0], o[1]); fa[0] = AT_VF(2, 0); AT_EXP(2); AT_ACC(1); AT_FMA(3, SP0, SP1); AT_SB(); \
        o[1] = AT_MF(AT_B8(fb[1]), PBO[1], o[1]); fa[1] = AT_VF(2, 1); AT_EXP(3); AT_ACC(2); AT_FMA(4, SP0, SP1); AT_SB(); \
        o[1] = AT_MF(AT_B8(fb[2]), PBO[2], o[1]); fa[2] = AT_VF(2, 2); AT_EXP(4); AT_ACC(3); AT_FMA(5, SP0, SP1); AT_SB(); \
        o[1] = AT_MF(AT_B8(fb[3]), PBO[3], o[1]); fa[3] = AT_VF(2, 3); AT_EXP(5); AT_ACC(4); AT_FMA(6, SP0, SP1); AT_SB(); \
        o[2] = AT_MF(AT_B8(fa[0]), PBO[0], o[2]); fb[0] = AT_VF(3, 0); AT_EXP(6); AT_ACC(5); AT_FMA(7, SP0, SP1); AT_SB(); \
        o[2] = AT_MF(AT_B8(fa[1]), PBO[1], o[2]); fb[1] = AT_VF(3, 1); AT_EXP(7); AT_ACC(6); AT_FMA(8, SP0, SP1); AT_SB(); \
        o[2] = AT_MF(AT_B8(fa[2]), PBO[2], o[2]); fb[2] = AT_VF(3, 2); AT_EXP(8); AT_ACC(7); AT_FMA(9, SP0, SP1); AT_SB(); \
        o[2] = AT_MF(AT_B8(fa[3]), PBO[3], o[2]); fb[3] = AT_VF(3, 3); AT_EXP(9); AT_ACC(8); AT_FMA(10, SP0, SP1); AT_SB(); \
        o[3] = AT_MF(AT_B8(fb[0]), PBO[0], o[3]); fa[0] = AT_KF(0, 0); AT_EXP(10); AT_ACC(9); AT_FMA(11, SP0, SP1); AT_SB(); \
        o[3] = AT_MF(AT_B8(fb[1]), PBO[1], o[3]); fa[1] = AT_KF(0, 1); AT_EXP(11); AT_ACC(10); AT_FMA(12, SP0, SP1); AT_SB(); \
        o[3] = AT_MF(AT_B8(fb[2]), PBO[2], o[3]); fa[2] = AT_KF(1, 0); AT_EXP(12); AT_ACC(11); AT_FMA(13, SP0, SP1); AT_SB(); \
        o[3] = AT_MF(AT_B8(fb[3]), PBO[3], o[3]); fa[3] = AT_KF(1, 1); bf16x8 qa_ = qf_(0); AT_EXP(13); AT_ACC(12); AT_FMA(14, SP0, SP1); AT_SB(); \
        SQ0 = AT_MF(AT_B8(fa[0]), qa_, (f32x16){}); fb[0] = AT_KF(2, 0); AT_EXP(14); AT_ACC(13); AT_FMA(15, SP0, SP1); AT_SB(); \
        SQ1 = AT_MF(AT_B8(fa[1]), qa_, (f32x16){}); fb[1] = AT_KF(2, 1); bf16x8 qb_ = qf_(1); AT_EXP(15); AT_ACC(14); AT_SB(); \
        SQ0 = AT_MF(AT_B8(fa[2]), qb_, SQ0); fb[2] = AT_KF(3, 0); AT_ACC(15); AT_SB(); \
        SQ1 = AT_MF(AT_B8(fa[3]), qb_, SQ1); fb[3] = AT_KF(3, 1); qa_ = qf_(2); AT_SB(); \
        SQ0 = AT_MF(AT_B8(fb[0]), qa_, SQ0); AT_WRKS(WS, t); AT_WRVS(WS, t); AT_SB();     \
        SQ1 = AT_MF(AT_B8(fb[1]), qa_, SQ1); qb_ = qf_(3); AT_SB(); \
        SQ0 = AT_MF(AT_B8(fb[2]), qb_, SQ0); AT_SB(); \
        SQ1 = AT_MF(AT_B8(fb[3]), qb_, SQ1); AT_SB(); \
        PBN[0] = AT_B8(wn_[0]); PBN[1] = AT_B8(wn_[1]); PBN[2] = AT_B8(wn_[2]); PBN[3] = AT_B8(wn_[3]); \
        if (need_) { const float alpha_ = __builtin_amdgcn_exp2f((m_reg - mn_) * C); l_reg *= alpha_; _Pragma("unroll") for (int dt = 0; dt < 4; ++dt) o[dt] = o[dt] * alpha_; } \
        l_reg += ps0_ + ps1_; m_reg = mn_; \
        AT_BAR(); \
    } while (0)
    for (int t = 0; t < NT; t += 2) {
        AT_ITER(t, sa0, sa1, sb0, sb1, pba, pbb, A, B);
        AT_ITER(t + 1, sb0, sb1, sa0, sa1, pbb, pba, B, A);
    }
    {
        const unsigned vb_ = AT_VB + vro;
#pragma unroll
        for (int dt = 0; dt < 4; ++dt)
#pragma unroll
            for (int s_ = 0; s_ < 4; ++s_) { const v4u aw = *(const LAS v4u*)(lds + vb_ + dt * 32 * AT_VP + s_ * 32);
                o[dt] = AT_MF(AT_B8(aw), pba[s_], o[dt]); }
    }
    AT_BAR();
#undef AT_BL
#undef AT_LDKS
#undef AT_LDVS
#undef AT_WRKS
#undef AT_WRVS
#undef AT_MF
#undef AT_B8
#undef AT_SB
#undef AT_SPV
#undef AT_FMA
#undef AT_EXP
#undef AT_ACC
#undef AT_VF
#undef AT_KF
#undef AT_ITER
#undef qf_
    const float linv = 1.f / (l_reg + __shfl_xor(l_reg, 32));
    LAS float* ex = (LAS float*)(lds + AT_EX) + (size_t)(g * 32 + n) * AT_EXP;
    if (j == 1) {
        const float sc = linv * lam;
#pragma unroll
        for (int t = 0; t < 4; ++t)
#pragma unroll
            for (int r4 = 0; r4 < 4; ++r4) { const int dv = 32 * t + 8 * r4 + 4 * hi;
                *(LAS f32x4*)(ex + dv) = (f32x4){o[t][4 * r4] * sc, o[t][4 * r4 + 1] * sc, o[t][4 * r4 + 2] * sc, o[t][4 * r4 + 3] * sc}; }
    }
    __syncthreads();
    if (j == 0) {
        float ss = 0.f;
#pragma unroll
        for (int t = 0; t < 4; ++t)
#pragma unroll
            for (int r4 = 0; r4 < 4; ++r4) { const int dv = 32 * t + 8 * r4 + 4 * hi; const f32x4 e = *(const LAS f32x4*)(ex + dv);
#pragma unroll
                for (int k = 0; k < 4; ++k) { const float v = o[t][4 * r4 + k] * linv - e[k]; o[t][4 * r4 + k] = v; ss += v * v; } }
        ss += __shfl_xor(ss, 32);
        const float rs = 0.8f / sqrtf(ss * (1.f / 128.f) + 1e-5f);
        bf16* orow = MIX + (size_t)(tokbase + q0 + n) * D + 512 + h * 128;
#pragma unroll
        for (int t = 0; t < 4; ++t)
#pragma unroll
            for (int p2 = 0; p2 < 2; ++p2) {
                u32x2 eo[2];
#pragma unroll
                for (int q = 0; q < 2; ++q) { const int r4 = 2 * p2 + q, dv = 32 * t + 8 * r4 + 4 * hi; const f32x4 w = *(const f32x4*)(subln + dv);
                    eo[q].x = pk2(o[t][4 * r4] * rs * w.x, o[t][4 * r4 + 1] * rs * w.y); eo[q].y = pk2(o[t][4 * r4 + 2] * rs * w.z, o[t][4 * r4 + 3] * rs * w.w); }
                const auto sx = __builtin_amdgcn_permlane32_swap(eo[0].x, eo[1].x, false, false), sy = __builtin_amdgcn_permlane32_swap(eo[0].y, eo[1].y, false, false);
                const v4u ov = {sx[0], sy[0], sx[1], sy[1]};
                *(v4u*)(orow + 32 * t + 8 * (2 * p2 + hi)) = ov; }
    }
    __syncthreads();
}
__global__ void __launch_bounds__(512, 2) hymba_fwd(Args a) {
    extern __shared__ __attribute__((aligned(16))) unsigned char lds_raw[];
    cg::grid_group grid = cg::this_grid();
    const ldsp lds = (ldsp)lds_raw;
    const int tid = threadIdx.x, lane = tid & 63, wid = __builtin_amdgcn_readfirstlane(tid >> 6);
    const int G = gridDim.x, bx = blockIdx.x, gw = bx * 8 + wid, NGW = G * 8;
    unsigned char* ws = a.ws;
    bf16* WIN = (bf16*)(ws + WS_WIN); bf16* WOUT = (bf16*)(ws + WS_WOUT); bf16* W1 = (bf16*)(ws + WS_W1); bf16* W2 = (bf16*)(ws + WS_W2);
    float* MOD = (float*)(ws + WS_MOD); float* ROT = (float*)(ws + WS_ROT); bf16* KRP = (bf16*)(ws + WS_KRP); bf16* KRS = (bf16*)(ws + WS_KRS);
    bf16* XN = (bf16*)(ws + WS_XN); bf16* UT = (bf16*)(ws + WS_UT); bf16* QK = (bf16*)(ws + WS_QK); bf16* VT = (bf16*)(ws + WS_VT); bf16* YT = (bf16*)(ws + WS_YT);
    bf16* HB = (bf16*)(ws + WS_H); bf16* MIX = XN;
    const int lo = a.ph_lo, hi_ = a.ph_hi;
#ifndef PHMASK
#define PHMASK 0xffffffffu
#endif
#define IN(k) (((PHMASK >> ((k) < PH_MLP0 ? (k) : ((k) == PH_FINAL ? 9 : 7 + (((k) - PH_MLP0) & 1)))) & 1u) && lo <= (k) && (k) < hi_)
#define SEAM(k) do { if (IN(k) && IN((k) + 1)) grid.sync(); } while (0)

    if (IN(PH_P0)) {
#ifndef P0_NO_ADALN
        for (int it = bx; it < 6144 / 64; it += G) adaln_item(lds, a, MOD, it, tid, wid, lane);
#endif
        LAS float* scr = (LAS float*)(lds + wid * 16384);
        constexpr int I_IN = (D / 64) * (DIN / 32), I_O = (D / 64) * (D / 32), I_1 = (D / 64) * (FF / 32), I_2 = (FF / 64) * (D / 32), NTR = I_IN + I_O + I_1 + I_2;
        constexpr int I_FP = L_P / 32, I_FS = L_S / 32;
#ifndef P0_NO_FILT
        for (int it = NGW - 1 - gw; it < 3 * (I_FP + I_FS); it += NGW) { const int q = it / 3, part = it - 3 * q, np0 = part == 0 ? 0 : (part == 1 ? 6 : 11), npn = part == 0 ? 6 : 5;
            if (q < I_FP) filter_item32(a, L_P, KRP, 32 * q, np0, npn, lane); else filter_item32(a, L_S, KRS, 32 * (q - I_FP), np0, npn, lane); }
#endif
        for (int it = gw; it < NTR; it += NGW) {
            int r = it;
            if (r < I_IN) { p0_transpose_item(a.in[7], D, DIN, WIN, 0, scr, r, lane); continue; } r -= I_IN;
            if (r < I_O) { p0_transpose_item(a.in[25], D, D, WOUT, 0, scr, r, lane); continue; } r -= I_O;
            if (r < I_1) { p0_transpose_item(a.in[27], D, FF, W1, 0, scr, r, lane); continue; } r -= I_1;
            p0_transpose_item(a.in[28], FF, D, W2, 0, scr, r, lane);
        }
#ifndef P0_NO_ROT
        for (int idx = bx * 512 + tid; idx < L_P * 8; idx += G * 512) { const int pos = idx >> 3, i = idx & 7;
            const float invf = powf(500000.0f, -(float)i / 8.0f); const float ang = (float)pos * invf;
            ROT[pos * 16 + i] = (float)cos((double)ang); ROT[pos * 16 + 8 + i] = (float)sin((double)ang); }
#endif
    }
    SEAM(PH_P0);
    if (IN(PH_XN1)) {
        for (int row = gw; row < TT; row += 2 * NGW) { const int rb_ = row + NGW; const int mb = batch_of_row(row); const float* xr = row < T_P ? a.in[0] + (size_t)row * D : a.in[1] + (size_t)(row - T_P) * D;
            if (rb_ < TT) { const int mb2 = batch_of_row(rb_); const float* xr2 = rb_ < T_P ? a.in[0] + (size_t)rb_ * D : a.in[1] + (size_t)(rb_ - T_P) * D;
                norm_row2<0>(xr, xr2, a.in[6], MOD + mb * 6144 + 1024, MOD + mb * 6144, MOD + mb2 * 6144 + 1024, MOD + mb2 * 6144, XN + (size_t)row * D, XN + (size_t)rb_ * D, nullptr, nullptr, 1e-6f, lane); }
            else norm_row<0>(xr, a.in[6], MOD + mb * 6144 + 1024, MOD + mb * 6144, XN + (size_t)row * D, nullptr, 1e-6f, lane); }
    }
    SEAM(PH_XN1);
    if (IN(PH_INPROJ)) {
        { pg8::Gemm g{WIN, XN, 1536, TT, D}; pg8::StaticOrder S; S.init(1536, TT, G, bx); pg8::EpiBf16<0, false> E{UT, TT, nullptr};
          pg8::gemm_phase<pg8::EpiBf16<0, false>, pg8::StaticOrder, PG8_ALIGN, PG8_SP2>(lds, g, S, E); }
        __syncthreads();
        { pg8::Gemm g{XN, WIN + (size_t)1536 * D, TT, 1024, D}; pg8::StaticOrder S; S.init(TT, 1024, G, bx); pg8::EpiBf16<0, true> E{QK, 1024, ROT};
          pg8::gemm_phase<pg8::EpiBf16<0, true>, pg8::StaticOrder, PG8_ALIGN, PG8_SP2>(lds, g, S, E); }
        __syncthreads();
        { pg8::Gemm g{WIN + (size_t)2560 * D, XN, 512, TT, D}; pg8::StaticOrder S; S.init(512, TT, G, bx); pg8::EpiBf16<0, false> E{VT, TT, nullptr};
          pg8::gemm_phase<pg8::EpiBf16<0, false>, pg8::StaticOrder, PG8_ALIGN, PG8_SP2>(lds, g, S, E); }
    }
    SEAM(PH_INPROJ);
    if (IN(PH_MIX)) {
        for (int u = bx; u < HW + 2 * HW; u += G) hyena_unit(lds, a, UT, KRP, KRS, YT, u, tid, wid, lane);
        const float lam = expf(wave_sum(a.in[20][lane] * a.in[21][lane])) - expf(wave_sum(a.in[22][lane] * a.in[23][lane])) + 0.2f;
        for (int u = bx; u < 1024 + 2048; u += G) {
            int mb, h, qb, tokbase, L;
            if (G == 256) {
                const int x = bx & 7, c = bx >> 3, r = u >> 8;
                if (r < 4) { mb = x >> 2; h = x & 3; qb = c + 32 * r; tokbase = mb * L_P; L = L_P; }
                else { const int w = c + 32 * (r - 4), p = (w >> 4) * 8 + x; mb = p >> 2; h = p & 3; qb = w & 15; tokbase = T_P + mb * L_S; L = L_S; }
            } else if (u < 1024) { mb = u >> 9; h = (u >> 7) & 3; qb = u & 127; tokbase = mb * L_P; L = L_P; }
            else { const int v = u - 1024; mb = v >> 6; h = (v >> 4) & 3; qb = v & 15; tokbase = T_P + mb * L_S; L = L_S; }
            attn_unit(lds, QK, VT, MIX, a.in[24], lam, tokbase, L, h, qb, tid, wid, lane);
        }
    }
    SEAM(PH_MIX);
    if (IN(PH_HNORM)) hnorm_phase(lds, a, YT, MIX, bx, G, tid, wid, lane);
    SEAM(PH_HNORM);
    if (IN(PH_OUTPROJ)) {
        pg8::Gemm g{MIX, WOUT, TT, D, D}; pg8::StaticOrder S; S.init(TT, D, G, bx); pg8::EpiGateRes E{a.in[0], a.in[1], a.out, MOD + 2048, 0};
        pg8::gemm_phase<pg8::EpiGateRes, pg8::StaticOrder, PG8_ALIGN, PG8_SP2>(lds, g, S, E);
    }
    SEAM(PH_OUTPROJ);
    if (IN(PH_XN2)) {
        for (int row = gw; row < TT; row += 2 * NGW) { const int rb_ = row + NGW; const int mb = batch_of_row(row);
            if (rb_ < TT) { const int mb2 = batch_of_row(rb_);
                norm_row2<0>(a.out + (size_t)row * D, a.out + (size_t)rb_ * D, a.in[26], MOD + mb * 6144 + 4096, MOD + mb * 6144 + 3072, MOD + mb2 * 6144 + 4096, MOD + mb2 * 6144 + 3072, XN + (size_t)row * D, XN + (size_t)rb_ * D, nullptr, nullptr, 1e-6f, lane); }
            else norm_row<0>(a.out + (size_t)row * D, a.in[26], MOD + mb * 6144 + 4096, MOD + mb * 6144 + 3072, XN + (size_t)row * D, nullptr, 1e-6f, lane); }
    }
    SEAM(PH_XN2);
    for (int ch = 0; ch < N_CHUNK; ++ch) {
        if (IN(PH_MLP0 + 2 * ch)) {
            pg8::Gemm g{XN + (size_t)ch * MLP_CHUNK * D, W1, MLP_CHUNK, FF, D}; pg8::StaticOrder S; S.init(MLP_CHUNK, FF, G, bx); pg8::EpiBf16<2, false> E{HB, FF, nullptr};
            pg8::gemm_phase<pg8::EpiBf16<2, false>, pg8::StaticOrder, PG8_ALIGN, PG8_SP2>(lds, g, S, E);
        }
        SEAM(PH_MLP0 + 2 * ch);
        if (IN(PH_MLP0 + 2 * ch + 1)) {
            pg8::Gemm g{HB, W2, MLP_CHUNK, D, FF}; pg8::StaticOrder S; S.init(MLP_CHUNK, D, G, bx); pg8::EpiGateRes E{nullptr, nullptr, a.out, MOD + 5120, ch * MLP_CHUNK};
            pg8::gemm_phase<pg8::EpiGateRes, pg8::StaticOrder, PG8_ALIGN, PG8_SP2>(lds, g, S, E);
        }
        SEAM(PH_MLP0 + 2 * ch + 1);
    }
    if (IN(PH_FINAL)) {
        for (int row = gw; row < TT; row += 2 * NGW) { const int rb_ = row + NGW;
            if (rb_ < TT) norm_row2<1>(a.out + (size_t)row * D, a.out + (size_t)rb_ * D, a.in[29], nullptr, nullptr, nullptr, nullptr, nullptr, nullptr, a.out + (size_t)row * D, a.out + (size_t)rb_ * D, 1e-6f, lane);
            else norm_row<1>(a.out + (size_t)row * D, a.in[29], nullptr, nullptr, nullptr, a.out + (size_t)row * D, 1e-6f, lane); }
    }
#undef IN
#undef SEAM
}

#ifndef MK_PER_PHASE
#define MK_PER_PHASE 0
#endif
extern "C" void kernel_launch(void* const* d_in, const int* in_sizes, int n_in, void* d_out, int out_size, void* d_ws, size_t ws_size, hipStream_t stream) {
    static int grid = 0;
    if (grid == 0) {
        if (n_in != 30 || out_size != TT * D || ws_size < WS_END) { fprintf(stderr, "kernel_launch: unexpected shapes (n_in %d out %d ws %zu)\n", n_in, out_size, ws_size); grid = -1; return; }
        int dev = 0, cus = 0, per_cu = 0;
        hipGetDevice(&dev); hipDeviceGetAttribute(&cus, hipDeviceAttributeMultiprocessorCount, dev);
        if (hipFuncSetAttribute((const void*)hymba_fwd, hipFuncAttributeMaxDynamicSharedMemorySize, LDS_BYTES) != hipSuccess) { fprintf(stderr, "kernel_launch: hipFuncSetAttribute failed\n"); grid = -1; return; }
        if (hipOccupancyMaxActiveBlocksPerMultiprocessor(&per_cu, (const void*)hymba_fwd, 512, LDS_BYTES) != hipSuccess || per_cu < 1) { fprintf(stderr, "kernel_launch: occupancy query says %d\n", per_cu); per_cu = 1; }
        (void)hipGetLastError();
        grid = cus * per_cu;
    }
    if (grid < 0) return;
    Args a{};
    for (int i = 0; i < 30; ++i) a.in[i] = (const float*)d_in[i];
    a.out = (float*)d_out; a.ws = (unsigned char*)d_ws;
#if MK_PER_PHASE
    for (int p = 0; p < N_PHASES; ++p) { a.ph_lo = p; a.ph_hi = p + 1; void* args[] = {&a};
        hipError_t e = hipLaunchCooperativeKernel((const void*)hymba_fwd, dim3(grid), dim3(512), args, LDS_BYTES, stream);
        if (e != hipSuccess) { fprintf(stderr, "launch %d failed: %s\n", p, hipGetErrorString(e)); break; } }
#else
    a.ph_lo = 0; a.ph_hi = N_PHASES; void* args[] = {&a};
    hipError_t e = hipLaunchCooperativeKernel((const void*)hymba_fwd, dim3(grid), dim3(512), args, LDS_BYTES, stream);
    if (e != hipSuccess) fprintf(stderr, "cooperative launch failed: %s (grid %d)\n", hipGetErrorString(e), grid);
#endif
}
```
